# Optimizing an MI355X kernel written in HIP

```python
import math
import jax, jax.numpy as jnp
from jax import lax
import numpy as np

D_MODEL = 1024
BATCH = 8
SEQ = 2048
DEPTH = 4
DEC_BATCH = 32
DEC_SEQ = 1
PAST_LEN = 8192
PAGE_SIZE = 128

N_A_LAYERS = DEPTH // 2
N_B_LAYERS = DEPTH - N_A_LAYERS
SSM_GROUP = 16
N_SSM_GROUPS = D_MODEL // SSM_GROUP
SSM_STATE = 64
DT_MIN = 1e-3
DT_MAX = 1e-1
DIL_WINDOWS = (128, 512, 2048)
DIL_RATES = (1, 4, 16)
N_DIL = 3
HEADS_PER_GROUP = 8
HEAD_DIM = 64
ATTN_WIDTH = HEADS_PER_GROUP * HEAD_DIM
D_FF = 2816
EPS = 1e-6
NEG = -1e30

kernel_name = 'yoco_s5_dilated_alibi_macaron'


def _rmsnorm(x, g):
    xf = x.astype(jnp.float32)
    y = xf * lax.rsqrt(jnp.mean(xf * xf, axis=-1, keepdims=True) + EPS)
    return (y * g.astype(jnp.float32)).astype(x.dtype)


def _swiglu(x, w_in, w_out):
    hcat = x @ w_in
    return (jax.nn.silu(hcat[..., :D_FF]) * hcat[..., D_FF:]) @ w_out


def _alibi_slopes():
    n = N_DIL * HEADS_PER_GROUP
    s = jnp.exp2(-8.0 * jnp.arange(1, n + 1, dtype=jnp.float32) / n)
    return s.reshape(N_DIL, HEADS_PER_GROUP)


def _cmul_combine(e1, e2):
    a1r, a1i, b1r, b1i = e1
    a2r, a2i, b2r, b2i = e2
    return (a2r * a1r - a2i * a1i,
            a2r * a1i + a2i * a1r,
            a2r * b1r - a2i * b1i + b2r,
            a2r * b1i + a2i * b1r + b2i)


def _s5_mixer(u, s0_re, s0_im, log_dt, lam_re, lam_im, b_re, b_im, c_re, c_im, d_skip, glu_w, glu_b):
    f32 = jnp.float32
    bn, t_len, _ = u.shape
    ug = u.astype(f32).reshape(bn, t_len, N_SSM_GROUPS, SSM_GROUP)
    dt = jnp.exp(log_dt.astype(f32))[:, None]
    lr = lam_re.astype(f32)
    li = lam_im.astype(f32)
    mag = jnp.exp(lr * dt)
    ar = mag * jnp.cos(li * dt)
    ai = mag * jnp.sin(li * dt)
    den = lr * lr + li * li
    cr = ((ar - 1.0) * lr + ai * li) / den
    ci = (ai * lr - (ar - 1.0) * li) / den
    br = b_re.astype(f32)
    bi = b_im.astype(f32)
    bbr = cr[..., None] * br - ci[..., None] * bi
    bbi = cr[..., None] * bi + ci[..., None] * br
    bu_r = jnp.einsum('btgh,gph->tbgp', ug, bbr)
    bu_i = jnp.einsum('btgh,gph->tbgp', ug, bbi)
    if s0_re is not None:
        s0r = s0_re.astype(f32)
        s0i = s0_im.astype(f32)
        bu_r = bu_r.at[0].add(ar * s0r - ai * s0i)
        bu_i = bu_i.at[0].add(ar * s0i + ai * s0r)
    a_r = jnp.broadcast_to(ar, (t_len, 1) + ar.shape)
    a_i = jnp.broadcast_to(ai, (t_len, 1) + ai.shape)
    _, _, xr, xi = lax.associative_scan(_cmul_combine, (a_r, a_i, bu_r, bu_i), axis=0)
    y = (jnp.einsum('tbgp,ghp->btgh', xr, c_re.astype(f32))
         - jnp.einsum('tbgp,ghp->btgh', xi, c_im.astype(f32))
         + d_skip.astype(f32) * ug)
    act = jax.nn.gelu(y.reshape(bn, t_len, D_MODEL))
    z = act @ glu_w + glu_b
    out = z[..., :D_MODEL] * jax.nn.sigmoid(z[..., D_MODEL:])
    return out, xr[-1], xi[-1]


def _to_strided(t, n_res, nb, r_len, dil):
    bn, s_len = t.shape[:2]
    rest = t.shape[2:]
    pad_rest = [(0, 0)] * len(rest)
    t = jnp.pad(t, [(0, 0), (0, n_res * dil - s_len)] + pad_rest)
    t = jnp.moveaxis(t.reshape((bn, n_res, dil) + rest), 2, 1)
    t = jnp.pad(t, [(0, 0), (0, 0), (0, nb * r_len - n_res)] + pad_rest)
    return t.reshape((bn, dil, nb, r_len) + rest)


def _from_strided(t, s_len, n_res):
    bn, dil, nb, r_len = t.shape[:4]
    rest = t.shape[4:]
    t = t.reshape((bn, dil, nb * r_len) + rest)[:, :, :n_res]
    t = jnp.moveaxis(t, 1, 2)
    return t.reshape((bn, n_res * dil) + rest)[:, :s_len]


def _dilated_attn_prompt(q, k, v, dil, window, slopes):
    f32 = jnp.float32
    bn, s_len, n_h, e = q.shape
    r_len = window // dil
    n_res = -(-s_len // dil)
    nb = -(-n_res // r_len)
    qs = _to_strided(q.astype(f32), n_res, nb, r_len, dil)
    ks = _to_strided(k.astype(f32), n_res, nb, r_len, dil)
    vs = _to_strided(v.astype(f32), n_res, nb, r_len, dil)

    def with_prev(t):
        prev = jnp.pad(t, [(0, 0), (0, 0), (1, 0)] + [(0, 0)] * 3)[:, :, :-1]
        return jnp.concatenate([prev, t], axis=3)

    kb = with_prev(ks)
    vb = with_prev(vs)
    s = jnp.einsum('bdnqhe,bdnkhe->bdnqhk', qs, kb) * (e ** -0.5)
    qi = jnp.arange(r_len)[:, None]
    kj = jnp.arange(2 * r_len)[None, :]
    diff = r_len + qi - kj
    kidx = (jnp.arange(nb)[:, None, None] - 1) * r_len + kj[None]
    valid = (diff >= 0) & (diff <= r_len) & (kidx >= 0)
    bias = -slopes[None, :, None] * (dil * diff).astype(f32)[:, None, :]
    s = jnp.where(valid[:, :, None, :], s + bias, NEG)
    m = jnp.max(s, axis=-1)
    p = jnp.exp(s - m[..., None])
    l = jnp.sum(p, axis=-1)
    acc = jnp.einsum('bdnqhk,bdnkhe->bdnqhe', p, vb)
    return (_from_strided(acc, s_len, n_res), _from_strided(m, s_len, n_res),
            _from_strided(l, s_len, n_res))


def _dilated_attn_sample(q, k_new, v_new, k_buf, v_buf, dil, window, slopes):
    f32 = jnp.float32
    e = q.shape[-1]
    t_len = q.shape[1]
    lb = k_buf.shape[1]
    r_len = window // dil
    kc = jnp.concatenate([k_buf.astype(f32), k_new.astype(f32)], axis=1)
    vc = jnp.concatenate([v_buf.astype(f32), v_new.astype(f32)], axis=1)
    ti = jnp.arange(t_len)[:, None]
    kk = jnp.arange(r_len + 1)[None, :]
    idx = lb + ti - kk * dil
    valid = idx >= 0
    idxc = jnp.maximum(idx, 0)
    kg = kc[:, idxc]
    vg = vc[:, idxc]
    s = jnp.einsum('bthe,btkhe->bthk', q.astype(f32), kg) * (e ** -0.5)
    bias = -slopes[:, None] * (dil * kk).astype(f32)
    s = jnp.where(valid[:, None, :], s + bias, NEG)
    m = jnp.max(s, axis=-1)
    p = jnp.exp(s - m[..., None])
    l = jnp.sum(p, axis=-1)
    acc = jnp.einsum('bthk,btkhe->bthe', p, vg)
    return acc, m, l


def _dilated_mixer(u, kv_groups, kv_bufs, w_q, w_o):
    bn, t_len, _ = u.shape
    q = (u @ w_q).reshape(bn, t_len, N_DIL, HEADS_PER_GROUP, HEAD_DIM)
    slopes = _alibi_slopes()
    accs, ms, ls = [], [], []
    for g in range(N_DIL):
        k = kv_groups[g][:, :, 0]
        v = kv_groups[g][:, :, 1]
        if kv_bufs is None:
            acc, m, l = _dilated_attn_prompt(q[:, :, g], k, v, DIL_RATES[g], DIL_WINDOWS[g], slopes[g])
        else:
            acc, m, l = _dilated_attn_sample(q[:, :, g], k, v, kv_bufs[g][:, :, 0], kv_bufs[g][:, :, 1],
                                             DIL_RATES[g], DIL_WINDOWS[g], slopes[g])
        accs.append(acc)
        ms.append(m)
        ls.append(l)
    m_all = jnp.stack(ms)
    l_all = jnp.stack(ls)
    acc_all = jnp.stack(accs)
    w = jnp.exp(m_all - jnp.max(m_all, axis=0, keepdims=True))
    den = jnp.sum(w * l_all, axis=0)
    merged = jnp.sum(w[..., None] * acc_all, axis=0) / den[..., None]
    return merged.reshape(bn, t_len, ATTN_WIDTH) @ w_o


def _trunk(x, ssm_re0, ssm_im0, kv_bufs, weights):
    (norm_ffn1, ffn1_w_in, ffn1_w_out, norm_mix, norm_ffn2, ffn2_w_in, ffn2_w_out, norm_kv, norm_final,
     ssm_log_dt, ssm_lambda_re, ssm_lambda_im, ssm_b_re, ssm_b_im, ssm_c_re, ssm_c_im, ssm_d, glu_w, glu_b,
     attn_w_q, attn_w_kv, attn_w_o) = weights
    bn, t_len, _ = x.shape
    h = x
    ssm_re, ssm_im = [], []
    kv_groups = None
    for layer in range(DEPTH):
        if layer == N_A_LAYERS:
            kv = (_rmsnorm(h, norm_kv) @ attn_w_kv).reshape(bn, t_len, N_DIL, 2, HEADS_PER_GROUP, HEAD_DIM)
            kv_groups = [kv[:, :, g] for g in range(N_DIL)]
        h = h + (0.5 * _swiglu(_rmsnorm(h, norm_ffn1[layer]), ffn1_w_in[layer], ffn1_w_out[layer])).astype(h.dtype)
        u = _rmsnorm(h, norm_mix[layer])
        if layer < N_A_LAYERS:
            s0r = None if ssm_re0 is None else ssm_re0[layer]
            s0i = None if ssm_im0 is None else ssm_im0[layer]
            mix, sr, si = _s5_mixer(u, s0r, s0i, ssm_log_dt[layer], ssm_lambda_re[layer], ssm_lambda_im[layer],
                                    ssm_b_re[layer], ssm_b_im[layer], ssm_c_re[layer], ssm_c_im[layer],
                                    ssm_d[layer], glu_w[layer], glu_b[layer])
            ssm_re.append(sr)
            ssm_im.append(si)
        else:
            b = layer - N_A_LAYERS
            mix = _dilated_mixer(u, kv_groups, kv_bufs, attn_w_q[b], attn_w_o[b])
        h = h + mix.astype(h.dtype)
        h = h + (0.5 * _swiglu(_rmsnorm(h, norm_ffn2[layer]), ffn2_w_in[layer], ffn2_w_out[layer])).astype(h.dtype)
    return _rmsnorm(h, norm_final), jnp.stack(ssm_re), jnp.stack(ssm_im), kv_groups


def setup_inputs(seed: int = 0) -> dict:
    key = jax.random.key(seed)
    ks = jax.random.split(key, 32)
    f32 = jnp.float32
    nrm = lambda k, shape, s: jax.random.normal(k, shape, f32) * s
    out = {}
    out['x_prompt'] = nrm(ks[0], (BATCH, SEQ, D_MODEL), 1.0)
    out['x_sample'] = nrm(ks[1], (DEC_BATCH, DEC_SEQ, D_MODEL), 1.0)
    out['state_ssm_re'] = nrm(ks[2], (N_A_LAYERS, DEC_BATCH, N_SSM_GROUPS, SSM_STATE), 0.3)
    out['state_ssm_im'] = nrm(ks[3], (N_A_LAYERS, DEC_BATCH, N_SSM_GROUPS, SSM_STATE), 0.3)
    out['cache_kv_w128'] = nrm(ks[4], (DEC_BATCH, min(DIL_WINDOWS[0], PAST_LEN), 2, HEADS_PER_GROUP, HEAD_DIM), 1.0)
    out['cache_kv_w512'] = nrm(ks[5], (DEC_BATCH, min(DIL_WINDOWS[1], PAST_LEN), 2, HEADS_PER_GROUP, HEAD_DIM), 1.0)
    out['cache_kv_w2048'] = nrm(ks[6], (DEC_BATCH, min(DIL_WINDOWS[2], PAST_LEN), 2, HEADS_PER_GROUP, HEAD_DIM), 1.0)
    out['norm_ffn1'] = 1.0 + nrm(ks[7], (DEPTH, D_MODEL), 0.02)
    out['ffn1_w_in'] = nrm(ks[8], (DEPTH, D_MODEL, 2 * D_FF), D_MODEL ** -0.5)
    out['ffn1_w_out'] = nrm(ks[9], (DEPTH, D_FF, D_MODEL), D_FF ** -0.5)
    out['norm_mix'] = 1.0 + nrm(ks[10], (DEPTH, D_MODEL), 0.02)
    out['norm_ffn2'] = 1.0 + nrm(ks[11], (DEPTH, D_MODEL), 0.02)
    out['ffn2_w_in'] = nrm(ks[12], (DEPTH, D_MODEL, 2 * D_FF), D_MODEL ** -0.5)
    out['ffn2_w_out'] = nrm(ks[13], (DEPTH, D_FF, D_MODEL), D_FF ** -0.5)
    out['norm_kv'] = 1.0 + nrm(ks[14], (D_MODEL,), 0.02)
    out['norm_final'] = 1.0 + nrm(ks[15], (D_MODEL,), 0.02)
    out['ssm_log_dt'] = jax.random.uniform(ks[16], (N_A_LAYERS, N_SSM_GROUPS), f32,
                                           math.log(DT_MIN), math.log(DT_MAX))
    out['ssm_lambda_re'] = -0.5 + nrm(ks[17], (N_A_LAYERS, N_SSM_GROUPS, SSM_STATE), 0.01)
    out['ssm_lambda_im'] = (math.pi * jnp.arange(SSM_STATE, dtype=f32))[None, None, :] + nrm(
        ks[18], (N_A_LAYERS, N_SSM_GROUPS, SSM_STATE), 0.01)
    b_scale = (2.0 * SSM_GROUP) ** -0.5
    out['ssm_b_re'] = nrm(ks[19], (N_A_LAYERS, N_SSM_GROUPS, SSM_STATE, SSM_GROUP), b_scale)
    out['ssm_b_im'] = nrm(ks[20], (N_A_LAYERS, N_SSM_GROUPS, SSM_STATE, SSM_GROUP), b_scale)
    out['ssm_c_re'] = nrm(ks[21], (N_A_LAYERS, N_SSM_GROUPS, SSM_GROUP, SSM_STATE), 0.5)
    out['ssm_c_im'] = nrm(ks[22], (N_A_LAYERS, N_SSM_GROUPS, SSM_GROUP, SSM_STATE), 0.5)
    out['ssm_d'] = nrm(ks[23], (N_A_LAYERS, N_SSM_GROUPS, SSM_GROUP), 1.0)
    out['glu_w'] = nrm(ks[24], (N_A_LAYERS, D_MODEL, 2 * D_MODEL), D_MODEL ** -0.5)
    out['glu_b'] = nrm(ks[25], (N_A_LAYERS, 2 * D_MODEL), 0.01)
    out['attn_w_q'] = nrm(ks[26], (N_B_LAYERS, D_MODEL, N_DIL * ATTN_WIDTH), D_MODEL ** -0.5)
    out['attn_w_kv'] = nrm(ks[27], (D_MODEL, N_DIL * 2 * ATTN_WIDTH), D_MODEL ** -0.5)
    out['attn_w_o'] = nrm(ks[28], (N_B_LAYERS, ATTN_WIDTH, D_MODEL), ATTN_WIDTH ** -0.5)
    return out


def reference(x_prompt, x_sample, state_ssm_re, state_ssm_im, cache_kv_w128, cache_kv_w512, cache_kv_w2048,
              norm_ffn1, ffn1_w_in, ffn1_w_out, norm_mix, norm_ffn2, ffn2_w_in, ffn2_w_out, norm_kv, norm_final,
              ssm_log_dt, ssm_lambda_re, ssm_lambda_im, ssm_b_re, ssm_b_im, ssm_c_re, ssm_c_im, ssm_d,
              glu_w, glu_b, attn_w_q, attn_w_kv, attn_w_o):
    weights = (norm_ffn1, ffn1_w_in, ffn1_w_out, norm_mix, norm_ffn2, ffn2_w_in, ffn2_w_out, norm_kv, norm_final,
               ssm_log_dt, ssm_lambda_re, ssm_lambda_im, ssm_b_re, ssm_b_im, ssm_c_re, ssm_c_im, ssm_d,
               glu_w, glu_b, attn_w_q, attn_w_kv, attn_w_o)
    y_prompt, ssm_re_p, ssm_im_p, kv_p = _trunk(x_prompt, None, None, None, weights)
    y_sample, ssm_re_s, ssm_im_s, kv_s = _trunk(x_sample, state_ssm_re, state_ssm_im,
                                                 (cache_kv_w128, cache_kv_w512, cache_kv_w2048), weights)
    s_len = x_prompt.shape[1]
    kv128_p = kv_p[0][:, s_len - min(DIL_WINDOWS[0], s_len):]
    kv512_p = kv_p[1][:, s_len - min(DIL_WINDOWS[1], s_len):]
    kv2048_p = kv_p[2][:, s_len - min(DIL_WINDOWS[2], s_len):]
    return (y_prompt, y_sample, ssm_re_p, ssm_im_p, kv128_p, kv512_p, kv2048_p,
            ssm_re_s, ssm_im_s, kv_s[0], kv_s[1], kv_s[2])
```

```cpp
#include <hip/hip_runtime.h>
#include <hip/hip_cooperative_groups.h>
#include <cstdio>
namespace cg = cooperative_groups;

#define LAS __attribute__((address_space(3)))
typedef short s16x4 __attribute__((ext_vector_type(4)));
typedef float f32x2 __attribute__((ext_vector_type(2)));
typedef float f32x16 __attribute__((ext_vector_type(16)));
typedef unsigned u32x2 __attribute__((ext_vector_type(2)));
typedef __bf16 bf16x2_t __attribute__((ext_vector_type(2)));

namespace pg8 {
#define PG8_LAS __attribute__((address_space(3)))
typedef unsigned short bf16_t;
typedef short bf16x8 __attribute__((ext_vector_type(8)));
typedef float f32x4 __attribute__((ext_vector_type(4)));
typedef unsigned u32x4 __attribute__((ext_vector_type(4)));
constexpr int BM = 256, BK = 64, HALF = 128, HTB = HALF * BK * 2  , STAGE_BYTES = 8 * HTB, NXCD = 8, WGM = 8;

__host__ __device__ __forceinline__ int lds_byte(int r, int c) { const int st = (r >> 4) * 2 + (c >> 5), rr = r & 15, cc = c & 31, ob = rr * 64 + cc * 2; return st * 1024 + (ob ^ (((ob >> 9) & 1) << 5)); }
__host__ __device__ __forceinline__ void stage_rc(int b, int& R, int& C) { const int st = b / 1024, sb = b % 1024, swz = sb ^ (((sb >> 9) & 1) << 5); R = (st >> 1) * 16 + swz / 64; C = (st & 1) * 32 + (swz % 64) / 2; }
__host__ __device__ __forceinline__ int perm32(int rho) { const int n = rho >> 4, i = rho & 15; return 8 * (i >> 2) + 4 * n + (i & 3); }

struct Unit { int pm, pn; };
struct Gemm { const bf16_t* A; const bf16_t* Bt; int M, N, K; };

struct StaticOrder {
    int nM, nN, nwg, G, c;
    __host__ __device__ void init(int M, int N, int G_, int c_) { nM = M / BM; nN = N / BM; nwg = nM * nN; G = G_; c = c_; }
    __host__ __device__ bool next(int i, Unit& u) const {
        const long L = (long)i * G + c; if (L >= nwg) return false;
        int wgid = (int)L; { const int q = nwg / NXCD, r = nwg % NXCD, xcd = wgid % NXCD, off = wgid / NXCD; wgid = (xcd < r ? xcd * (q + 1) : r * (q + 1) + (xcd - r) * q) + off; }
        const int nig = WGM * nN, gid = wgid / nig, fm = gid * WGM, gsz = (nM - fm) < WGM ? (nM - fm) : WGM;
        u.pm = fm + ((wgid % nig) % gsz); u.pn = (wgid % nig) / gsz; return true;
    }
    __device__ __forceinline__ void a_ready(const Unit&) const {}
    __device__ __forceinline__ void done(const Unit&) const {}
};
template <class Epi, class Sched>
__device__ __forceinline__ void gemm_phase(PG8_LAS unsigned char* lds, const Gemm g, const Sched& S, const Epi& E) {
    const int tid = threadIdx.x, wid = __builtin_amdgcn_readfirstlane(tid >> 6), lane = tid & 63, wr = wid >> 2, wc = wid & 3, fr = lane & 15, fq = lane >> 4;
    const int K = g.K, nt = K / BK;
    unsigned voffA[2], voffB[2];
#pragma unroll
    for (int i = 0; i < 2; ++i) { int R, C; stage_rc(tid * 16 + i * 8192, R, C); const int Rb = Epi::PERM ? ((R & ~31) + perm32(R & 31)) : R;
        voffA[i] = (unsigned)(R * K + C) * 2u; voffB[i] = (unsigned)(Rb * K + C) * 2u; }
    const size_t kstep = (size_t)(BK * 2);
    const size_t hstep = (size_t)HALF * K * 2;
    const size_t tstep = 2 * hstep;
    const unsigned ldsw = (unsigned)wid * 1024u;
    const int aoff = lds_byte(wr * 64 + fr, fq * 8), boff = lds_byte(wc * 32 + fr, fq * 8);
#define PG8_SA(b, h) (((b) * 2 + (h)) * HTB)
#define PG8_SB(b, h) ((4 + (b) * 2 + (h)) * HTB)
#define PG8_STAGE(bufoff, gbase, voff) do { _Pragma("unroll") for (int _i = 0; _i < 2; ++_i) \
        __builtin_amdgcn_global_load_lds((const unsigned*)((const char*)(gbase) + (voff)[_i]), (PG8_LAS unsigned*)(lds + (bufoff) + ldsw + _i * 8192), 16, 0, 0); } while (0)
#define PG8_LDA(dst, b, h) do { _Pragma("unroll") for (int m = 0; m < 4; ++m) _Pragma("unroll") for (int k = 0; k < 2; ++k) dst[m][k] = *(const PG8_LAS bf16x8*)(lds + PG8_SA(b, h) + aoff + m * 2048 + k * 1024); } while (0)
#define PG8_LDB(dst, b, h) do { _Pragma("unroll") for (int n = 0; n < 2; ++n) _Pragma("unroll") for (int k = 0; k < 2; ++k) dst[n][k] = *(const PG8_LAS bf16x8*)(lds + PG8_SB(b, h) + boff + n * 2048 + k * 1024); } while (0)
#define PG8_MMA(ai, bj, At, Bt) do { __builtin_amdgcn_s_setprio(1); _Pragma("unroll") for (int m = 0; m < 4; ++m) _Pragma("unroll") for (int n = 0; n < 2; ++n) _Pragma("unroll") for (int k = 0; k < 2; ++k) \
        acc[ai][bj][m][n] = __builtin_amdgcn_mfma_f32_16x16x32_bf16(Bt[n][k], At[m][k], acc[ai][bj][m][n], 0, 0, 0); __builtin_amdgcn_s_setprio(0); } while (0)
#define PG8_WAIT_V(n) asm volatile("s_waitcnt vmcnt(" #n ")" ::: "memory")
#define PG8_WAIT_L(n) asm volatile("s_waitcnt lgkmcnt(" #n ")" ::: "memory")
#define PG8_BAR __builtin_amdgcn_s_barrier()
#define PG8_SCHED __builtin_amdgcn_sched_barrier(0)
    Unit cur, nxt; int ui = 0;
    if (!S.next(0, cur)) return;
    f32x4 acc[2][2][4][2];
#pragma unroll
    for (int a = 0; a < 2; ++a)
#pragma unroll
        for (int b = 0; b < 2; ++b)
#pragma unroll
            for (int m = 0; m < 4; ++m)
#pragma unroll
                for (int n = 0; n < 2; ++n) acc[a][b][m][n] = (f32x4){0.f, 0.f, 0.f, 0.f};
    bf16x8 At[4][2], B0[2][2], B1[2][2];
    const char* cA = (const char*)g.A + (size_t)cur.pm * tstep; const char* cB = (const char*)g.Bt + (size_t)cur.pn * tstep;
    S.a_ready(cur);
    PG8_STAGE(PG8_SB(0, 0), cB, voffB); PG8_STAGE(PG8_SA(0, 0), cA, voffA); PG8_STAGE(PG8_SB(0, 1), cB + hstep, voffB); PG8_STAGE(PG8_SA(0, 1), cA + hstep, voffA);
    if (wr == 1) PG8_BAR;
    PG8_WAIT_V(4); PG8_BAR;
    PG8_STAGE(PG8_SB(1, 0), cB + kstep, voffB); PG8_STAGE(PG8_SA(1, 0), cA + kstep, voffA); PG8_STAGE(PG8_SB(1, 1), cB + hstep + kstep, voffB);
    PG8_WAIT_V(6); PG8_BAR;
    for (;;) {
        const bool has_next = S.next(ui + 1, nxt);
        const char* nA = has_next ? (const char*)g.A + (size_t)nxt.pm * tstep : cA; const char* nB = has_next ? (const char*)g.Bt + (size_t)nxt.pn * tstep : cB;
        for (int t = 0; t < nt; t += 2) {
            const bool last = (t == nt - 2);
            const char* a1 = cA + (size_t)(t + 1) * kstep;
            const char* a2 = last ? nA : cA + (size_t)(t + 2) * kstep; const char* b2 = last ? nB : cB + (size_t)(t + 2) * kstep;
            const char* a3 = a2 + kstep; const char* b3 = b2 + kstep;
            if (last && has_next) S.a_ready(nxt);
            PG8_LDB(B0, 0, 0); PG8_SCHED; PG8_LDA(At, 0, 0); PG8_STAGE(PG8_SA(1, 1), a1 + hstep, voffA);
            PG8_WAIT_L(8); PG8_BAR; PG8_WAIT_L(0); PG8_MMA(0, 0, At, B0); PG8_BAR; PG8_SCHED;
            PG8_LDB(B1, 0, 1); PG8_STAGE(PG8_SB(0, 0), b2, voffB);
            PG8_BAR; PG8_WAIT_L(0); PG8_MMA(0, 1, At, B1); PG8_BAR;
            PG8_LDA(At, 0, 1); PG8_STAGE(PG8_SA(0, 0), a2, voffA);
            PG8_BAR; PG8_WAIT_L(0); PG8_MMA(1, 0, At, B0); PG8_BAR; PG8_SCHED;
            PG8_STAGE(PG8_SB(0, 1), b2 + hstep, voffB);
            PG8_WAIT_V(6); PG8_BAR; PG8_MMA(1, 1, At, B1); PG8_BAR;
            PG8_LDB(B0, 1, 0); PG8_SCHED; PG8_LDA(At, 1, 0); PG8_STAGE(PG8_SA(0, 1), a2 + hstep, voffA);
            PG8_WAIT_L(8); PG8_BAR; PG8_WAIT_L(0); PG8_MMA(0, 0, At, B0); PG8_BAR; PG8_SCHED;
            PG8_LDB(B1, 1, 1); PG8_STAGE(PG8_SB(1, 0), b3, voffB);
            PG8_BAR; PG8_WAIT_L(0); PG8_MMA(0, 1, At, B1); PG8_BAR;
            PG8_LDA(At, 1, 1); PG8_STAGE(PG8_SA(1, 0), a3, voffA);
            PG8_BAR; PG8_WAIT_L(0); PG8_MMA(1, 0, At, B0); PG8_BAR; PG8_SCHED;
            PG8_STAGE(PG8_SB(1, 1), b3 + hstep, voffB);
            PG8_WAIT_V(6); PG8_BAR; PG8_MMA(1, 1, At, B1); PG8_BAR;
        }
        if constexpr (!Epi::AFTER_DRAIN) { E(acc, cur, wr, wc, fr, fq); S.done(cur); }
        if (!has_next) break;
#pragma unroll
        for (int a = 0; a < 2; ++a)
#pragma unroll
            for (int b = 0; b < 2; ++b)
#pragma unroll
                for (int m = 0; m < 4; ++m)
#pragma unroll
                    for (int n = 0; n < 2; ++n) acc[a][b][m][n] = (f32x4){0.f, 0.f, 0.f, 0.f};
        cur = nxt; cA = nA; cB = nB; ++ui;
    }
    PG8_WAIT_V(0);
    if (wr == 0) PG8_BAR;
    PG8_BAR;
    if constexpr (Epi::AFTER_DRAIN) { E.fused(acc, cur, wr, wc, fr, fq, lds, wid, lane); S.done(cur); }
#undef PG8_SA
#undef PG8_SB
#undef PG8_STAGE
#undef PG8_LDA
#undef PG8_LDB
#undef PG8_MMA
#undef PG8_WAIT_V
#undef PG8_WAIT_L
#undef PG8_BAR
#undef PG8_SCHED
}
}

using pg8::bf16_t; using pg8::bf16x8; using pg8::f32x4; using pg8::u32x4;

constexpr int D = 1024, SEQ = 2048, NBATCH = 8, MP = NBATCH * SEQ, NSMP = 32, MT = MP + NSMP, FF = 2816, NKVC = 3072, NQC = 1536, AW = 512;
constexpr int NWAVES = 8, NTHREADS = 512;
constexpr float EPS = 1e-6f;
constexpr int SSQ_STRIDE = 16640;
constexpr size_t O_Y = 0, O_YS = (size_t)MP * D, O_SRP = O_YS + (size_t)NSMP * D, O_SIP = O_SRP + 65536, O_KV128 = O_SIP + 65536,
                 O_KV512 = O_KV128 + (size_t)8 * 128 * 1024, O_KV2048 = O_KV512 + (size_t)8 * 512 * 1024, O_SRS = O_KV2048 + (size_t)8 * 2048 * 1024,
                 O_SIS = O_SRS + 262144, O_KVS128 = O_SIS + 262144, O_KVS512 = O_KVS128 + 32768, O_KVS2048 = O_KVS512 + 32768, O_END = O_KVS2048 + 32768;
constexpr size_t al256(size_t x) { return (x + 255) & ~(size_t)255; }
constexpr size_t SZ_UP = (size_t)2 * FF * D * 2, SZ_DN = (size_t)D * FF * 2, SZ_GLU = (size_t)2 * D * D * 2, SZ_Q = (size_t)NQC * D * 2, SZ_KV = (size_t)NKVC * D * 2, SZ_O = (size_t)D * AW * 2;
constexpr size_t WS_CTL = 0, CTL_BYTES = 65536;
constexpr size_t WS_SSQ = CTL_BYTES;
constexpr size_t WS_WUP = al256(WS_SSQ + (size_t)13 * SSQ_STRIDE * 8);
constexpr size_t WS_WDN = WS_WUP + 8 * SZ_UP + SZ_KV;
constexpr size_t WS_WGLU = WS_WDN + 8 * SZ_DN;
constexpr size_t WS_WQ = WS_WGLU + 2 * SZ_GLU;
constexpr size_t WS_WO = WS_WQ + 2 * SZ_Q;
constexpr size_t WS_HB = WS_WO + 2 * SZ_O;
constexpr size_t WS_ACT = al256(WS_HB + (size_t)MT * D * 2);
constexpr size_t WS_GACT = al256(WS_ACT + (size_t)MT * FF * 2);
constexpr size_t WS_KVB = al256(WS_GACT + (size_t)MT * D * 2);
constexpr size_t WS_QB = al256(WS_KVB + (size_t)MT * NKVC * 2);
constexpr size_t WS_AO = al256(WS_QB + (size_t)MT * NQC * 2);
constexpr size_t WS_PO = al256(WS_AO + (size_t)MT * AW * 2);
constexpr size_t WS_PM = al256(WS_PO + (size_t)2 * MP * AW * 2);
constexpr size_t WS_PL = al256(WS_PM + (size_t)2 * MP * 8 * 4);
constexpr size_t WS_END = al256(WS_PL + (size_t)2 * MP * 8 * 4);
constexpr int LDS_BYTES = 163840;

struct Params { const float* in[29]; float* out; unsigned char* ws; };

#define LDS_WAIT() asm volatile("s_waitcnt lgkmcnt(0)" ::: "memory")
__device__ __forceinline__ unsigned pk_bf16(float lo, float hi) { f32x2 v = {lo, hi}; return __builtin_bit_cast(unsigned, __builtin_convertvector(v, bf16x2_t)); }
__device__ __forceinline__ float bf2f(unsigned short b) { return __uint_as_float(((unsigned)b) << 16); }
__device__ __forceinline__ unsigned short f2bf(float f) { return (unsigned short)(pk_bf16(f, 0.f) & 0xffffu); }
__device__ __forceinline__ void st_bf16x4(bf16_t* p, f32x4 v) { u32x2 w; w.x = pk_bf16(v[0], v[1]); w.y = pk_bf16(v[2], v[3]); *(u32x2*)p = w; }
__device__ __forceinline__ float sigm_f(float a) { return __builtin_amdgcn_rcpf(1.0f + __expf(-a)); }
__device__ __forceinline__ float silu_f(float a) { return a * sigm_f(a); }
__device__ __forceinline__ float gelu_tanh_f(float y) { return y * sigm_f(1.5957691216f * (y + 0.044715f * y * y * y)); }
typedef unsigned long long ssq_t;
__device__ __forceinline__ ssq_t ssq_fix(float ss) { return (ssq_t)(ss * 1048576.0f + 0.5f); }
__device__ __forceinline__ float rstd_of(const ssq_t* ssq, int row) { return 1.0f / sqrtf((float)ssq[row] * (1.0f / (1048576.0f * 1024.0f)) + EPS); }
__device__ __forceinline__ float wave_sum(float v) {
#pragma unroll
    for (int o = 1; o < 64; o <<= 1) v += __shfl_xor(v, o);
    return v;
}
__device__ __forceinline__ float wave_max(float v) {
#pragma unroll
    for (int o = 1; o < 64; o <<= 1) v = fmaxf(v, __shfl_xor(v, o));
    return v;
}
__device__ __forceinline__ int crow(int i, int h) { return (i & 3) + 8 * (i >> 2) + 4 * h; }

#define XB_TMO      128
#define XB_XCNT(j)  (256  + 64 * (j))
#define XB_XSUB(j)  (1280 + 64 * (j))
#define XB_XGEN(j)  (2304 + 64 * (j))
#define XB_TOP      3328
#define XB_TOPGEN   3392
#define XCD_BAR_WORDS 3456
#define XB_SPIN_CAP (1u << 18)

__device__ __forceinline__ unsigned xb_ld(unsigned* p)              { return __hip_atomic_load(p, __ATOMIC_RELAXED, __HIP_MEMORY_SCOPE_AGENT); }
__device__ __forceinline__ unsigned xb_add(unsigned* p, unsigned v) { return __hip_atomic_fetch_add(p, v, __ATOMIC_RELAXED, __HIP_MEMORY_SCOPE_AGENT); }
__device__ __forceinline__ unsigned xb_xcc_id() { return (unsigned)__builtin_amdgcn_s_getreg((3 << 11) | 20) & 0xFu; }
#define XB_SPIN(cond, bar) do { unsigned _sp = 0; while (cond) { __builtin_amdgcn_s_sleep(1); \
    if ((++_sp & 255u) == 0u) { if (xb_ld(&(bar)[XB_TMO])) break; if (_sp > XB_SPIN_CAP) { atomicAdd(&(bar)[XB_TMO], 1u); break; } } } } while (0)

struct XcdBarrier {
    unsigned* bar; unsigned x;
    volatile LAS unsigned* st;
};

__device__ __forceinline__ XcdBarrier xcd_barrier_post(unsigned* bar, volatile LAS unsigned* st) {
    XcdBarrier b; b.bar = bar; b.x = xb_xcc_id(); b.st = st;
    if (threadIdx.x == 0) (void)xb_add(&bar[XB_XCNT(b.x)], 1u);
    return b;
}
__device__ __forceinline__ void xcd_barrier_complete(unsigned* bar, unsigned x, unsigned& nloc, unsigned& nx) {
    const unsigned G = gridDim.x * gridDim.y * gridDim.z;
    unsigned sum, cnt, mine, sp = 0u;
    for (;;) {
        sum = 0u; cnt = 0u; mine = 0u;
#pragma unroll
        for (unsigned j = 0; j < 16; ++j) { const unsigned c = xb_ld(&bar[XB_XCNT(j)]); sum += c; cnt += (c > 0u) ? 1u : 0u; mine = (j == x) ? c : mine; }
        if (sum == G) break;
        __builtin_amdgcn_s_sleep(1);
        if ((++sp & 255u) == 0u) { if (xb_ld(&bar[XB_TMO])) break; if (sp > XB_SPIN_CAP) { atomicAdd(&bar[XB_TMO], 1u); break; } }
    }
    nloc = mine > 0u ? mine : 1u; nx = cnt > 0u ? cnt : 1u;
}

__device__ __forceinline__ void xcd_barrier(const XcdBarrier& b) {
    asm volatile("s_waitcnt vmcnt(0)" ::: "memory");
    __syncthreads();
    if (threadIdx.x == 0) {
        unsigned* bar = b.bar;
        __builtin_amdgcn_s_waitcnt(0);
        unsigned nloc = b.st[0], nx = b.st[1];
        if (nloc == 0u) { xcd_barrier_complete(bar, b.x, nloc, nx); b.st[0] = nloc; b.st[1] = nx; }
        const unsigned old = xb_add(&bar[XB_XSUB(b.x)], 1u);
        const unsigned gen = old / nloc;
        if (old + 1u == (gen + 1u) * nloc) {
            __builtin_amdgcn_fence(__ATOMIC_RELEASE, "agent");
            asm volatile("s_waitcnt vmcnt(0)" ::: "memory");
            const unsigned og = xb_add(&bar[XB_TOP], 1u);
            const unsigned tg = og / nx;
            if (og + 1u == (tg + 1u) * nx) xb_add(&bar[XB_TOPGEN], 1u);
            else XB_SPIN(xb_ld(&bar[XB_TOPGEN]) == tg, bar);
            __builtin_amdgcn_fence(__ATOMIC_ACQUIRE, "agent");
            xb_add(&bar[XB_XGEN(b.x)], 1u);
            asm volatile("s_waitcnt vmcnt(0)" ::: "memory");
        } else {
            XB_SPIN(xb_ld(&bar[XB_XGEN(b.x)]) == gen, bar);
            __builtin_amdgcn_fence(__ATOMIC_ACQUIRE, "agent");
            asm volatile("s_waitcnt vmcnt(0)" ::: "memory");
        }
    }
    __syncthreads();
}

enum { EP_UP = 0, EP_RES = 1, EP_GLU = 2, EP_Q = 3 };
struct Epi {
    static constexpr bool PERM = false, AFTER_DRAIN = false;
    int mode, nkv;
    const ssq_t* ssq_in;
    ssq_t* ssq_out;
    bf16_t* obf;
    bf16_t* kvb;
    float* h;
    const float* base_p;
    const float* base_s;
    const float* bias;
    float* out;
    float scale;

    __device__ __forceinline__ void el_up(int row, int fcol, f32x4 a, f32x4 b, float rs) const {
        f32x4 v;
#pragma unroll
        for (int j = 0; j < 4; ++j) v[j] = silu_f(a[j] * rs) * (b[j] * rs);
        st_bf16x4(obf + (size_t)row * FF + fcol, v);
    }
    __device__ __forceinline__ void el_kv(int row, int c, f32x4 a, float rs) const {
        const f32x4 v = a * rs;
        st_bf16x4(kvb + (size_t)row * NKVC + c, v);
        const int g = c >> 10, rem = c & 1023;
        if (row < MP) {
            const int b = row >> 11, t = row & 2047, Wg = 128 << (2 * g), t0 = SEQ - Wg;
            if (t >= t0) { float* o = out + (g == 0 ? O_KV128 : (g == 1 ? O_KV512 : O_KV2048)) + ((size_t)(b * Wg + t - t0)) * 1024 + rem; *(f32x4*)o = v; }
        } else {
            float* o = out + (g == 0 ? O_KVS128 : (g == 1 ? O_KVS512 : O_KVS2048)) + (size_t)(row - MP) * 1024 + rem; *(f32x4*)o = v;
        }
    }
    __device__ __forceinline__ float el_res(int row, int col, f32x4 a) const {
        const float* bp = (row < MP) ? base_p + (size_t)row * D + col : base_s + (size_t)(row - MP) * D + col;
        const f32x4 v = *(const f32x4*)bp + scale * a;
        *(f32x4*)(h + (size_t)row * D + col) = v;
        st_bf16x4(obf + (size_t)row * D + col, v);
        return (v[0] * v[0] + v[1] * v[1]) + (v[2] * v[2] + v[3] * v[3]);
    }
    __device__ __forceinline__ float el_glu(int row, int col, f32x4 a, f32x4 b) const {
        const f32x4 b1 = *(const f32x4*)(bias + col), b2 = *(const f32x4*)(bias + D + col);
        const f32x4 hv = *(const f32x4*)(h + (size_t)row * D + col);
        f32x4 v;
#pragma unroll
        for (int j = 0; j < 4; ++j) v[j] = hv[j] + (a[j] + b1[j]) * sigm_f(b[j] + b2[j]);
        *(f32x4*)(h + (size_t)row * D + col) = v;
        st_bf16x4(obf + (size_t)row * D + col, v);
        return (v[0] * v[0] + v[1] * v[1]) + (v[2] * v[2] + v[3] * v[3]);
    }
    __device__ __forceinline__ void el_q(int row, int c, f32x4 a, float rs) const {
        const f32x4 v = a * (rs * 0.125f);
        st_bf16x4(obf + (size_t)row * NQC + c, v);
    }
    __device__ __forceinline__ void ssq_add(int row, float ss, int fq) const {
        ss += __shfl_xor(ss, 16); ss += __shfl_xor(ss, 32);
        if (fq == 0) atomicAdd(ssq_out + row, ssq_fix(ss));
    }
    __device__ __forceinline__ void operator()(const f32x4 (&acc)[2][2][4][2], const pg8::Unit& u, int wr, int wc, int fr, int fq) const {
        const int row0 = u.pm * 256 + wr * 64 + fr;
        if (mode == EP_UP) {
            if (u.pn >= nkv) {
                const int f0 = (u.pn - nkv) * 128 + wc * 32 + 4 * fq;
#pragma unroll
                for (int ai = 0; ai < 2; ++ai)
#pragma unroll
                    for (int m = 0; m < 4; ++m) { const int row = row0 + ai * 128 + m * 16; const float rs = rstd_of(ssq_in, row);
#pragma unroll
                        for (int n = 0; n < 2; ++n) el_up(row, f0 + n * 16, acc[ai][0][m][n], acc[ai][1][m][n], rs); }
            } else {
                const int c0 = u.pn * 256 + wc * 32 + 4 * fq;
#pragma unroll
                for (int ai = 0; ai < 2; ++ai)
#pragma unroll
                    for (int m = 0; m < 4; ++m) { const int row = row0 + ai * 128 + m * 16; const float rs = rstd_of(ssq_in, row);
#pragma unroll
                        for (int bj = 0; bj < 2; ++bj)
#pragma unroll
                            for (int n = 0; n < 2; ++n) el_kv(row, c0 + bj * 128 + n * 16, acc[ai][bj][m][n], rs); }
            }
        } else if (mode == EP_RES) {
            const int c0 = u.pn * 256 + wc * 32 + 4 * fq;
#pragma unroll
            for (int ai = 0; ai < 2; ++ai)
#pragma unroll
                for (int m = 0; m < 4; ++m) { const int row = row0 + ai * 128 + m * 16; float ss = 0.f;
#pragma unroll
                    for (int bj = 0; bj < 2; ++bj)
#pragma unroll
                        for (int n = 0; n < 2; ++n) ss += el_res(row, c0 + bj * 128 + n * 16, acc[ai][bj][m][n]);
                    ssq_add(row, ss, fq); }
        } else if (mode == EP_GLU) {
            const int c0 = u.pn * 128 + wc * 32 + 4 * fq;
#pragma unroll
            for (int ai = 0; ai < 2; ++ai)
#pragma unroll
                for (int m = 0; m < 4; ++m) { const int row = row0 + ai * 128 + m * 16; float ss = 0.f;
#pragma unroll
                    for (int n = 0; n < 2; ++n) ss += el_glu(row, c0 + n * 16, acc[ai][0][m][n], acc[ai][1][m][n]);
                    ssq_add(row, ss, fq); }
        } else {
            const int c0 = u.pn * 256 + wc * 32 + 4 * fq;
#pragma unroll
            for (int ai = 0; ai < 2; ++ai)
#pragma unroll
                for (int m = 0; m < 4; ++m) { const int row = row0 + ai * 128 + m * 16; const float rs = rstd_of(ssq_in, row);
#pragma unroll
                    for (int bj = 0; bj < 2; ++bj)
#pragma unroll
                        for (int n = 0; n < 2; ++n) el_q(row, c0 + bj * 128 + n * 16, acc[ai][bj][m][n], rs); }
        }
    }
};

__device__ __forceinline__ void small_gemm(const Epi& E, const bf16_t* A  , const bf16_t* Bt, int K, int lane, int wave) {
    const int r16 = lane & 15, q4 = lane >> 4;
    int nitems;
    if (E.mode == EP_UP) nitems = 176 + E.nkv * 16; else if (E.mode == EP_Q) nitems = 96; else nitems = 64;
    for (int it = blockIdx.x + gridDim.x * wave; it < nitems; it += gridDim.x * NWAVES) {
        int n0 = 0, n1 = 0, ocol = 0; bool kvstrip = false;
        if (E.mode == EP_UP) {
            if (it < E.nkv * 16) { kvstrip = true; n0 = 16 * it; n1 = n0; ocol = n0; }
            else { const int p = it - E.nkv * 16, pnu = p >> 3, s = p & 7; n0 = E.nkv * 256 + pnu * 256 + 16 * s; n1 = n0 + 128; ocol = pnu * 128 + 16 * s; }
        } else if (E.mode == EP_GLU) { const int pn = it >> 3, s = it & 7; n0 = pn * 256 + 16 * s; n1 = n0 + 128; ocol = pn * 128 + 16 * s; }
        else { n0 = 16 * it; n1 = n0; ocol = n0; }
        const bf16_t* a0p = A + (size_t)r16 * K + 8 * q4; const bf16_t* a1p = a0p + (size_t)16 * K;
        const bf16_t* b0p = Bt + (size_t)(n0 + r16) * K + 8 * q4; const bf16_t* b1p = Bt + (size_t)(n1 + r16) * K + 8 * q4;
        f32x4 acc00 = {0.f, 0.f, 0.f, 0.f}, acc01 = acc00, acc10 = acc00, acc11 = acc00;
#pragma unroll 4
        for (int kk = 0; kk < K; kk += 32) {
            const bf16x8 a0 = *(const bf16x8*)(a0p + kk), a1 = *(const bf16x8*)(a1p + kk), b0 = *(const bf16x8*)(b0p + kk), b1 = *(const bf16x8*)(b1p + kk);
            acc00 = __builtin_amdgcn_mfma_f32_16x16x32_bf16(b0, a0, acc00, 0, 0, 0);
            acc01 = __builtin_amdgcn_mfma_f32_16x16x32_bf16(b0, a1, acc01, 0, 0, 0);
            acc10 = __builtin_amdgcn_mfma_f32_16x16x32_bf16(b1, a0, acc10, 0, 0, 0);
            acc11 = __builtin_amdgcn_mfma_f32_16x16x32_bf16(b1, a1, acc11, 0, 0, 0);
        }
        const int col = ocol + 4 * q4;
#pragma unroll
        for (int rt = 0; rt < 2; ++rt) {
            const int row = MP + 16 * rt + r16; const f32x4 va = rt ? acc01 : acc00, vb = rt ? acc11 : acc10;
            if (E.mode == EP_UP) { const float rs = rstd_of(E.ssq_in, row); if (kvstrip) E.el_kv(row, col, va, rs); else E.el_up(row, col, va, vb, rs); }
            else if (E.mode == EP_RES) { const float ss = E.el_res(row, col, va); E.ssq_add(row, ss, q4); }
            else if (E.mode == EP_GLU) { const float ss = E.el_glu(row, col, va, vb); E.ssq_add(row, ss, q4); }
            else { const float rs = rstd_of(E.ssq_in, row); E.el_q(row, col, va, rs); }
        }
    }
}

struct MatDesc { const float* W; const float* g; bf16_t* WT; int K, N, half; };
__device__ __forceinline__ bf16_t* wup_ptr(unsigned char* ws, int i) { return (bf16_t*)(ws + WS_WUP + (size_t)i * SZ_UP + (i >= 4 ? SZ_KV : 0)); }
__device__ __forceinline__ bf16_t* wkv_ptr(unsigned char* ws) { return (bf16_t*)(ws + WS_WUP + 4 * SZ_UP); }
__device__ __forceinline__ MatDesc mat_desc(const Params& P, int mi) {
    MatDesc d;
    if (mi < 8) { const int l = mi >> 1, f = mi & 1; d.W = P.in[f ? 12 : 8] + (size_t)l * D * 2 * FF; d.g = P.in[f ? 11 : 7] + l * D; d.WT = wup_ptr(P.ws, mi); d.K = D; d.N = 2 * FF; d.half = FF; }
    else if (mi < 16) { const int i = mi - 8, l = i >> 1, f = i & 1; d.W = P.in[f ? 13 : 9] + (size_t)l * FF * D; d.g = nullptr; d.WT = (bf16_t*)(P.ws + WS_WDN + (size_t)i * SZ_DN); d.K = FF; d.N = D; d.half = 0; }
    else if (mi < 18) { const int l = mi - 16; d.W = P.in[24] + (size_t)l * D * 2 * D; d.g = nullptr; d.WT = (bf16_t*)(P.ws + WS_WGLU + (size_t)l * SZ_GLU); d.K = D; d.N = 2 * D; d.half = D; }
    else if (mi < 20) { const int b = mi - 18; d.W = P.in[26] + (size_t)b * D * NQC; d.g = P.in[10] + (2 + b) * D; d.WT = (bf16_t*)(P.ws + WS_WQ + (size_t)b * SZ_Q); d.K = D; d.N = NQC; d.half = 0; }
    else if (mi == 20) { d.W = P.in[27]; d.g = P.in[14]; d.WT = wkv_ptr(P.ws); d.K = D; d.N = NKVC; d.half = 0; }
    else { const int b = mi - 21; d.W = P.in[28] + (size_t)b * AW * D; d.g = nullptr; d.WT = (bf16_t*)(P.ws + WS_WO + (size_t)b * SZ_O); d.K = AW; d.N = D; d.half = 0; }
    return d;
}
__device__ __forceinline__ void conv_item(const MatDesc& d, LAS float* scr, int item, int lane) {
    const int nblk = d.N / 32, kb = item / nblk, nb = item % nblk, k0 = 64 * kb, n0 = 32 * nb;
    int n0p = n0;
    if (d.half) { const int second = n0 >= d.half, m = second ? n0 - d.half : n0; n0p = 256 * (m >> 7) + (second ? 128 : 0) + (m & 127); }
#pragma unroll 8
    for (int i = 0; i < 32; ++i) { const int kk = 2 * i + (lane >> 5); float v = d.W[(size_t)(k0 + kk) * d.N + n0 + (lane & 31)]; if (d.g) v *= d.g[k0 + kk]; scr[kk * 33 + (lane & 31)] = v; }
    LDS_WAIT();
    const int c = lane & 7;
#pragma unroll
    for (int j = 0; j < 4; ++j) { const int n = (lane >> 3) + 8 * j; const LAS float* s = scr + (8 * c) * 33 + n;
        u32x4 o; o.x = pk_bf16(s[0 * 33], s[1 * 33]); o.y = pk_bf16(s[2 * 33], s[3 * 33]); o.z = pk_bf16(s[4 * 33], s[5 * 33]); o.w = pk_bf16(s[6 * 33], s[7 * 33]);
        *(u32x4*)(d.WT + (size_t)(n0p + n) * d.K + k0 + 8 * c) = o; }
    LDS_WAIT();
}
__device__ __forceinline__ void prologue(const Params& P, LAS unsigned char* lds, int lane, int wave) {
    LAS float* scr = (LAS float*)(lds + wave * 16384);
    const int gw = blockIdx.x * NWAVES + wave, NGW = gridDim.x * NWAVES;
    int rot = 0;
    for (int mi = 0; mi < 23; ++mi) {
        const MatDesc d = mat_desc(P, mi);
        const int nitems = (d.K / 64) * (d.N / 32);
        int first = gw - rot; if (first < 0) first += NGW;
        for (int it = first; it < nitems; it += NGW) conv_item(d, scr, it, lane);
        rot = (rot + nitems) % NGW;
    }
    bf16_t* HB = (bf16_t*)(P.ws + WS_HB); ssq_t* SSQ = (ssq_t*)(P.ws + WS_SSQ);
    for (int row = gw; row < MT; row += NGW) {
        const float* src = row < MP ? P.in[0] + (size_t)row * D : P.in[1] + (size_t)(row - MP) * D;
        float ss = 0.f;
#pragma unroll
        for (int j = 0; j < 4; ++j) { const f32x4 v = *(const f32x4*)(src + 4 * lane + 256 * j); ss += (v[0] * v[0] + v[1] * v[1]) + (v[2] * v[2] + v[3] * v[3]); st_bf16x4(HB + (size_t)row * D + 4 * lane + 256 * j, v); }
        ss = wave_sum(ss);
        if (lane == 0) SSQ[row] = ssq_fix(ss);
    }
    for (int i = blockIdx.x * NTHREADS + threadIdx.x; i < 12 * SSQ_STRIDE; i += gridDim.x * NTHREADS) SSQ[SSQ_STRIDE + i] = 0ull;
}
__device__ __forceinline__ void final_norm(const Params& P, int lane, int wave) {
    const int gw = blockIdx.x * NWAVES + wave, NGW = gridDim.x * NWAVES;
    const ssq_t* SSQ = (const ssq_t*)(P.ws + WS_SSQ) + 12 * SSQ_STRIDE; const float* g = P.in[15];
    for (int row = gw; row < MT; row += NGW) {
        const float rs = rstd_of(SSQ, row); float* hp = P.out + (size_t)row * D;
#pragma unroll
        for (int j = 0; j < 4; ++j) { const f32x4 v = *(const f32x4*)(hp + 4 * lane + 256 * j), gv = *(const f32x4*)(g + 4 * lane + 256 * j); *(f32x4*)(hp + 4 * lane + 256 * j) = v * rs * gv; }
    }
}

#define MFMA32(a, b, c) __builtin_amdgcn_mfma_f32_32x32x16_bf16((a), (b), (c), 0, 0, 0)
__device__ __forceinline__ bf16x8 pack8(float a0, float a1, float a2, float a3, float a4, float a5, float a6, float a7) {
    u32x4 w; w.x = pk_bf16(a0, a1); w.y = pk_bf16(a2, a3); w.z = pk_bf16(a4, a5); w.w = pk_bf16(a6, a7); return __builtin_bit_cast(bf16x8, w);
}
struct Disc { float ar, ai, cr, ci, a16r, a16i; };
__device__ __forceinline__ Disc ssm_disc(const Params& P, int lg, int p) {
    Disc d; const float dt = expf(P.in[16][lg]), lr = P.in[17][lg * 64 + p], li = P.in[18][lg * 64 + p];
    const float mag = expf(lr * dt), ang = li * dt; d.ar = mag * cosf(ang); d.ai = mag * sinf(ang);
    const float den = lr * lr + li * li; d.cr = ((d.ar - 1.0f) * lr + d.ai * li) / den; d.ci = (d.ai * lr - (d.ar - 1.0f) * li) / den;
    const float mag16 = expf(lr * dt * 16.0f), ang16 = ang * 16.0f; d.a16r = mag16 * cosf(ang16); d.a16i = mag16 * sinf(ang16);
    return d;
}
__device__ __forceinline__ void ssm_sample_item(const Params& P, int layer, int item, int lane, const ssq_t* SSQ) {
    const int b = item >> 6, g = item & 63, row = MP + b, p = lane, lg = layer * 64 + g;
    const float rs = rstd_of(SSQ, row);
    const Disc dc = ssm_disc(P, lg, p);
    const float* hrow = P.out + (size_t)row * D + g * 16; const float* gm = P.in[10] + layer * D + g * 16;
    const float* brp = P.in[19] + ((size_t)lg * 64 + p) * 16; const float* bip = P.in[20] + ((size_t)lg * 64 + p) * 16;
    float bur = 0.f, bui = 0.f;
#pragma unroll
    for (int ch = 0; ch < 16; ++ch) { const float u = hrow[ch] * rs * gm[ch], br = brp[ch], bi = bip[ch]; bur += u * (dc.cr * br - dc.ci * bi); bui += u * (dc.cr * bi + dc.ci * br); }
    const size_t si = (((size_t)layer * NSMP + b) * 64 + g) * 64 + p;
    const float s0r = P.in[2][si], s0i = P.in[3][si];
    const float xr = dc.ar * s0r - dc.ai * s0i + bur, xi = dc.ar * s0i + dc.ai * s0r + bui;
    P.out[O_SRS + si] = xr; P.out[O_SIS + si] = xi;
    float myy = 0.f;
#pragma unroll
    for (int hh = 0; hh < 16; ++hh) { const float part = xr * P.in[21][((size_t)lg * 16 + hh) * 64 + p] - xi * P.in[22][((size_t)lg * 16 + hh) * 64 + p]; const float tot = wave_sum(part); if (lane == hh) myy = tot; }
    if (lane < 16) { const float u = hrow[lane] * rs * gm[lane]; const float y = myy + P.in[23][lg * 16 + lane] * u;
        ((bf16_t*)(P.ws + WS_GACT))[(size_t)row * D + g * 16 + lane] = f2bf(gelu_tanh_f(y)); }
}
__device__ __forceinline__ void ssm_prompt(const Params& P, int layer, LAS unsigned char* lds, const ssq_t* SSQ, int tid, int lane, int wave) {
    LAS float* Sre = (LAS float*)lds;
    LAS float* Sim = (LAS float*)(lds + 66560);
    LAS float* LA = (LAS float*)(lds + 133120);
    LAS float* LA16 = (LAS float*)(lds + 134144);
    LAS float* LC = (LAS float*)(lds + 135168);
    const bf16_t* HB = (const bf16_t*)(P.ws + WS_HB); bf16_t* GACT = (bf16_t*)(P.ws + WS_GACT);
    const int r = lane & 31, half = lane >> 5, it2 = wave >> 2, w4 = wave & 3, c = 32 * w4 + r;
    f32x16 zero16;
#pragma unroll
    for (int i = 0; i < 16; ++i) zero16[i] = 0.f;
    for (int pair = blockIdx.x; pair < 256; pair += gridDim.x) {
        const int item = 2 * pair + it2, b = item >> 6, g = item & 63, lg = layer * 64 + g;
        __syncthreads();
        if (tid < 128) { const int j2 = tid >> 6, p = tid & 63, itm = 2 * pair + j2; const Disc dc = ssm_disc(P, layer * 64 + (itm & 63), p); const int o = (j2 * 64 + p) * 2;
            LA[o] = dc.ar; LA[o + 1] = dc.ai; LA16[o] = dc.a16r; LA16[o + 1] = dc.a16i; LC[o] = dc.cr; LC[o + 1] = dc.ci; }
        __syncthreads();
        bf16x8 bfr[2], bfi[2];
#pragma unroll
        for (int pt = 0; pt < 2; ++pt) { const int p = 32 * pt + r; const float cr = LC[(it2 * 64 + p) * 2], ci = LC[(it2 * 64 + p) * 2 + 1];
            const float* brp = P.in[19] + ((size_t)lg * 64 + p) * 16 + 4 * half; const float* bip = P.in[20] + ((size_t)lg * 64 + p) * 16 + 4 * half; const float* gm = P.in[10] + layer * D + g * 16 + 4 * half;
            float vr[8], vi[8];
#pragma unroll
            for (int j = 0; j < 8; ++j) { const int o = (j & 3) + 8 * (j >> 2); const float br = brp[o], bi = bip[o], gmv = gm[o]; vr[j] = (cr * br - ci * bi) * gmv; vi[j] = (cr * bi + ci * br) * gmv; }
            bfr[pt] = pack8(vr[0], vr[1], vr[2], vr[3], vr[4], vr[5], vr[6], vr[7]); bfi[pt] = pack8(vi[0], vi[1], vi[2], vi[3], vi[4], vi[5], vi[6], vi[7]); }
        LAS bf16x8* LCF = (LAS bf16x8*)(lds + 136192) + it2 * 512;
        if (w4 == 0) {
#pragma unroll
            for (int tau = 0; tau < 4; ++tau)
#pragma unroll
                for (int s = 0; s < 2; ++s) { const float* cp = (tau < 2 ? P.in[21] : P.in[22]) + ((size_t)lg * 16 + (r & 15)) * 64 + 32 * (tau & 1) + 16 * s + 4 * half; const float sg = (r < 16) ? (tau < 2 ? 1.0f : -1.0f) : 0.0f;
                    LCF[(tau * 2 + s) * 64 + lane] = pack8(cp[0] * sg, cp[1] * sg, cp[2] * sg, cp[3] * sg, cp[8] * sg, cp[9] * sg, cp[10] * sg, cp[11] * sg); }
        }
        float dsk[8];
#pragma unroll
        for (int i = 0; i < 8; ++i) { const int hh = (i & 3) + 8 * (i >> 2) + 4 * half; dsk[i] = P.in[23][lg * 16 + hh] * P.in[10][layer * D + g * 16 + hh]; }
        const size_t row0 = (size_t)b * SEQ + 16 * c;
        const LAS float* la = LA + (it2 * 64 + 4 * half) * 2;
        float xr[2][16], xi[2][16];
#pragma unroll
        for (int pt = 0; pt < 2; ++pt)
#pragma unroll
            for (int i = 0; i < 16; ++i) { xr[pt][i] = 0.f; xi[pt][i] = 0.f; }
#define SSM_STEP_UPDATE(ub, rs) do { _Pragma("unroll") for (int pt = 0; pt < 2; ++pt) { const f32x16 bur = MFMA32(bfr[pt], ub, zero16), bui = MFMA32(bfi[pt], ub, zero16); \
            _Pragma("unroll") for (int q = 0; q < 4; ++q) { const f32x4 a01 = *(const LAS f32x4*)(la + (32 * pt + 8 * q) * 2), a23 = *(const LAS f32x4*)(la + (32 * pt + 8 * q) * 2 + 4); \
                const float av[8] = {a01[0], a01[1], a01[2], a01[3], a23[0], a23[1], a23[2], a23[3]}; \
                _Pragma("unroll") for (int e = 0; e < 4; ++e) { const int i = 4 * q + e; const float ar = av[2 * e], ai = av[2 * e + 1]; \
                    const float nr = ar * xr[pt][i] - ai * xi[pt][i] + (rs) * bur[i], ni = ar * xi[pt][i] + ai * xr[pt][i] + (rs) * bui[i]; xr[pt][i] = nr; xi[pt][i] = ni; } \
                __builtin_amdgcn_sched_barrier(0); } } } while (0)
        for (int t0 = 0; t0 < 16; ++t0) {
            const size_t row = row0 + t0; const bf16_t* up = HB + row * D + g * 16 + 4 * half;
            const s16x4 u0 = *(const s16x4*)up, u1 = *(const s16x4*)(up + 8); const bf16x8 ub = __builtin_shufflevector(u0, u1, 0, 1, 2, 3, 4, 5, 6, 7);
            const float rs = rstd_of(SSQ, (int)row);
            SSM_STEP_UPDATE(ub, rs);
        }
#pragma unroll
        for (int pt = 0; pt < 2; ++pt)
#pragma unroll
            for (int i = 0; i < 16; ++i) { const int p = 32 * pt + crow(i, half), o = (it2 * 128 + c) * 65 + p; Sre[o] = xr[pt][i]; Sim[o] = xi[pt][i]; }
        __syncthreads();
        if (tid < 128) { const int j2 = tid >> 6, p = tid & 63; const float a16r = LA16[(j2 * 64 + p) * 2], a16i = LA16[(j2 * 64 + p) * 2 + 1]; float rr = 0.f, ri = 0.f;
            for (int cc = 0; cc < 128; ++cc) { const int o = (j2 * 128 + cc) * 65 + p; const float sr = Sre[o], si = Sim[o]; Sre[o] = rr; Sim[o] = ri;
                const float nr = a16r * rr - a16i * ri + sr, ni = a16r * ri + a16i * rr + si; rr = nr; ri = ni; }
            const int itm = 2 * pair + j2; const size_t so = (((size_t)layer * NBATCH + (itm >> 6)) * 64 + (itm & 63)) * 64 + p;
            P.out[O_SRP + so] = rr; P.out[O_SIP + so] = ri; }
        __syncthreads();
#pragma unroll
        for (int pt = 0; pt < 2; ++pt)
#pragma unroll
            for (int i = 0; i < 16; ++i) { const int p = 32 * pt + crow(i, half), o = (it2 * 128 + c) * 65 + p; xr[pt][i] = Sre[o]; xi[pt][i] = Sim[o]; }
        for (int t0 = 0; t0 < 16; ++t0) {
            const size_t row = row0 + t0; const bf16_t* up = HB + row * D + g * 16 + 4 * half;
            const s16x4 u0 = *(const s16x4*)up, u1 = *(const s16x4*)(up + 8); const bf16x8 ub = __builtin_shufflevector(u0, u1, 0, 1, 2, 3, 4, 5, 6, 7);
            const float rs = rstd_of(SSQ, (int)row);
            SSM_STEP_UPDATE(ub, rs);
            f32x16 yT = zero16;
#pragma unroll
            for (int pt = 0; pt < 2; ++pt)
#pragma unroll
                for (int s = 0; s < 2; ++s) {
                    const bf16x8 xsr = pack8(xr[pt][8 * s], xr[pt][8 * s + 1], xr[pt][8 * s + 2], xr[pt][8 * s + 3], xr[pt][8 * s + 4], xr[pt][8 * s + 5], xr[pt][8 * s + 6], xr[pt][8 * s + 7]);
                    const bf16x8 xsi = pack8(xi[pt][8 * s], xi[pt][8 * s + 1], xi[pt][8 * s + 2], xi[pt][8 * s + 3], xi[pt][8 * s + 4], xi[pt][8 * s + 5], xi[pt][8 * s + 6], xi[pt][8 * s + 7]);
                    yT = MFMA32(LCF[(pt * 2 + s) * 64 + lane], xsr, yT); yT = MFMA32(LCF[((2 + pt) * 2 + s) * 64 + lane], xsi, yT); __builtin_amdgcn_sched_barrier(0); }
            f32x4 y0, y1;
#pragma unroll
            for (int i = 0; i < 4; ++i) { y0[i] = gelu_tanh_f(yT[i] + dsk[i] * (bf2f((unsigned short)ub[i]) * rs)); y1[i] = gelu_tanh_f(yT[4 + i] + dsk[4 + i] * (bf2f((unsigned short)ub[4 + i]) * rs)); }
            bf16_t* op = GACT + row * D + g * 16 + 4 * half; st_bf16x4(op, y0); st_bf16x4(op + 8, y1);
        }
#undef SSM_STEP_UPDATE
    }
}

__device__ __forceinline__ void attn_tile(const Params& P, int b, int hs, int g, int rho, int i0, int lane, bool last) {
    const bf16_t* QB = (const bf16_t*)(P.ws + WS_QB); const bf16_t* KVB = (const bf16_t*)(P.ws + WS_KVB);
    bf16_t* PO = (bf16_t*)(P.ws + WS_PO); float* PM = (float*)(P.ws + WS_PM); float* PL = (float*)(P.ws + WS_PL); bf16_t* AO = (bf16_t*)(P.ws + WS_AO);
    const int r = lane & 31, half = lane >> 5, d = 1 << (2 * g);
    const int iq = i0 + r; const size_t rowq = (size_t)b * SEQ + rho + d * iq;
    const float slope_d = exp2f(-(float)(g * 8 + hs + 1) * (1.0f / 3.0f)) * (float)d;
    f32x16 zero16;
#pragma unroll
    for (int i = 0; i < 16; ++i) zero16[i] = 0.f;
    bf16x8 qf[4];
#pragma unroll
    for (int s = 0; s < 4; ++s) qf[s] = *(const bf16x8*)(QB + rowq * NQC + g * 512 + hs * 64 + 16 * s + 8 * half);
    const int lim = iq < 128 ? iq : 128;
    float m = -1e20f, l = 0.f;
    f32x16 o0 = zero16, o1 = zero16;
    const bf16_t* vbase = KVB + ((size_t)b * SEQ + rho) * NKVC + g * 1024 + 512 + hs * 64 + r;
#pragma unroll 1
    for (int kt = 0; kt < 5; ++kt) {
        int ik = i0 - 128 + 32 * kt + r; ik = ik < 0 ? 0 : ik;
        const bf16_t* kp = KVB + ((size_t)b * SEQ + rho + d * ik) * NKVC + g * 1024 + hs * 64 + 8 * half;
        f32x16 st = zero16;
#pragma unroll
        for (int s = 0; s < 4; ++s) st = MFMA32(*(const bf16x8*)(kp + 16 * s), qf[s], st);
        float tm = -1e30f;
        const int dbase = r + 128 - 32 * kt - 4 * half;
#pragma unroll
        for (int i = 0; i < 16; ++i) { const int diff = dbase - ((i & 3) + 8 * (i >> 2)); const bool valid = diff >= 0 && diff <= lim;
            const float sv = valid ? st[i] - slope_d * (float)diff : -1e30f; st[i] = sv; tm = fmaxf(tm, sv); }
        tm = fmaxf(tm, __shfl_xor(tm, 32));
        const float mn = fmaxf(m, tm), alpha = __expf(m - mn); m = mn;
        float ls = 0.f;
#pragma unroll
        for (int i = 0; i < 16; ++i) { const float p = __expf(st[i] - mn); st[i] = p; ls += p; }
        ls += __shfl_xor(ls, 32);
        l = l * alpha + ls;
#pragma unroll
        for (int i = 0; i < 16; ++i) { o0[i] *= alpha; o1[i] *= alpha; }
#pragma unroll
        for (int s2 = 0; s2 < 2; ++s2) {
            const bf16x8 pf = pack8(st[8 * s2], st[8 * s2 + 1], st[8 * s2 + 2], st[8 * s2 + 3], st[8 * s2 + 4], st[8 * s2 + 5], st[8 * s2 + 6], st[8 * s2 + 7]);
            bf16x8 v0, v1;
#pragma unroll
            for (int j = 0; j < 8; ++j) { int key = i0 - 128 + 32 * kt + 16 * s2 + 8 * (j >> 2) + 4 * half + (j & 3); key = key < 0 ? 0 : key;
                const bf16_t* vp = vbase + (size_t)(d * key) * NKVC; v0[j] = (short)vp[0]; v1[j] = (short)vp[32]; }
            o0 = MFMA32(v0, pf, o0); o1 = MFMA32(v1, pf, o1);
        }
    }
    if (!last) {
        const float inv = 1.0f / l; const size_t pr = (size_t)(g - 1) * MP + rowq;
#pragma unroll
        for (int q = 0; q < 4; ++q) { const int e0 = 8 * q + 4 * half;
            st_bf16x4(PO + pr * AW + hs * 64 + e0, (f32x4){o0[4 * q] * inv, o0[4 * q + 1] * inv, o0[4 * q + 2] * inv, o0[4 * q + 3] * inv});
            st_bf16x4(PO + pr * AW + hs * 64 + 32 + e0, (f32x4){o1[4 * q] * inv, o1[4 * q + 1] * inv, o1[4 * q + 2] * inv, o1[4 * q + 3] * inv}); }
        if (half == 0) { PM[pr * 8 + hs] = m; PL[pr * 8 + hs] = l; }
    } else {
        const size_t p1 = rowq, p2 = (size_t)MP + rowq;
        const float m1 = PM[p1 * 8 + hs], l1 = PL[p1 * 8 + hs], m2 = PM[p2 * 8 + hs], l2 = PL[p2 * 8 + hs];
        const float mm = fmaxf(m, fmaxf(m1, m2)); const float w0 = __expf(m - mm), w1 = __expf(m1 - mm) * l1, w2 = __expf(m2 - mm) * l2;
        const float inv = 1.0f / (w0 * l + w1 + w2);
#pragma unroll
        for (int q = 0; q < 4; ++q)
#pragma unroll
            for (int et = 0; et < 2; ++et) { const int e0 = 32 * et + 8 * q + 4 * half;
                const u32x2 a = *(const u32x2*)(PO + p1 * AW + hs * 64 + e0), c = *(const u32x2*)(PO + p2 * AW + hs * 64 + e0);
                const float a0 = __uint_as_float(a.x << 16), a1 = __uint_as_float(a.x & 0xffff0000u), a2 = __uint_as_float(a.y << 16), a3 = __uint_as_float(a.y & 0xffff0000u);
                const float c0 = __uint_as_float(c.x << 16), c1 = __uint_as_float(c.x & 0xffff0000u), c2 = __uint_as_float(c.y << 16), c3 = __uint_as_float(c.y & 0xffff0000u);
                f32x4 v;
                v[0] = (w0 * (et ? o1[4 * q] : o0[4 * q]) + w1 * a0 + w2 * c0) * inv; v[1] = (w0 * (et ? o1[4 * q + 1] : o0[4 * q + 1]) + w1 * a1 + w2 * c1) * inv;
                v[2] = (w0 * (et ? o1[4 * q + 2] : o0[4 * q + 2]) + w1 * a2 + w2 * c2) * inv; v[3] = (w0 * (et ? o1[4 * q + 3] : o0[4 * q + 3]) + w1 * a3 + w2 * c3) * inv;
                st_bf16x4(AO + rowq * AW + hs * 64 + e0, v); }
    }
}
__device__ __forceinline__ void attn_sample_item(const Params& P, int item, int lane, LAS float* sl) {
    const bf16_t* QB = (const bf16_t*)(P.ws + WS_QB); const bf16_t* KVB = (const bf16_t*)(P.ws + WS_KVB); bf16_t* AO = (bf16_t*)(P.ws + WS_AO);
    const int b = item >> 3, hs = item & 7; const size_t row = (size_t)MP + b;
#pragma unroll
    for (int g = 0; g < 3; ++g) sl[g * 64 + lane] = bf2f(QB[row * NQC + g * 512 + hs * 64 + lane]);
    LDS_WAIT();
    float m = -1e30f;
#pragma unroll 1
    for (int g = 0; g < 3; ++g) {
        const int d = 1 << (2 * g), Lb = 128 * d; const float slope_d = exp2f(-(float)(g * 8 + hs + 1) * (1.0f / 3.0f)) * (float)d; const float* cache = P.in[4 + g];
#pragma unroll 1
        for (int ch = 0; ch < 3; ++ch) { const int kk = ch * 64 + lane; float s = -1e30f;
            if (kk <= 128) { float dot = 0.f;
                if (kk == 0) { const bf16_t* kp = KVB + row * NKVC + g * 1024 + hs * 64;
#pragma unroll 1
                    for (int e = 0; e < 64; ++e) dot += sl[g * 64 + e] * bf2f(kp[e]); }
                else { const float* kp = cache + (((size_t)b * Lb + (size_t)(128 - kk) * d) * 2 + 0) * 512 + hs * 64;
#pragma unroll 4
                    for (int e = 0; e < 64; e += 4) { const f32x4 kv = *(const f32x4*)(kp + e); const f32x4 qv = *(const LAS f32x4*)(sl + g * 64 + e); dot += (kv[0] * qv[0] + kv[1] * qv[1]) + (kv[2] * qv[2] + kv[3] * qv[3]); } }
                s = dot - slope_d * (float)kk; }
            sl[192 + g * 192 + ch * 64 + lane] = s; m = fmaxf(m, s); }
    }
    m = wave_max(m);
    float l = 0.f;
#pragma unroll 1
    for (int idx = 0; idx < 9; ++idx) { const int j = 192 + idx * 64 + lane; const float p = __expf(sl[j] - m); l += p; sl[j] = p; }
    l = wave_sum(l);
    LDS_WAIT();
    float acc = 0.f;
#pragma unroll 1
    for (int g = 0; g < 3; ++g) {
        const int d = 1 << (2 * g), Lb = 128 * d; const float* cache = P.in[4 + g];
        acc += sl[192 + g * 192] * bf2f(KVB[row * NKVC + g * 1024 + 512 + hs * 64 + lane]);
#pragma unroll 4
        for (int kk = 1; kk <= 128; ++kk) acc += sl[192 + g * 192 + kk] * cache[(((size_t)b * Lb + (size_t)(128 - kk) * d) * 2 + 1) * 512 + hs * 64 + lane];
    }
    AO[row * AW + hs * 64 + lane] = f2bf(acc / l);
    LDS_WAIT();
}

__global__ void __launch_bounds__(NTHREADS, 2) yoco_fwd(Params P) {
    extern __shared__ __attribute__((aligned(16))) unsigned char shm[];
    LAS unsigned char* lds = (LAS unsigned char*)shm;
    const int tid = threadIdx.x, lane = tid & 63, wave = __builtin_amdgcn_readfirstlane(tid >> 6);
    cg::grid_group grid = cg::this_grid();
    volatile LAS unsigned* MISC = (volatile LAS unsigned*)(lds + LDS_BYTES - 64);
    if (tid < 16) MISC[tid] = 0u;
    __syncthreads();
    XcdBarrier bar = xcd_barrier_post((unsigned*)(P.ws + WS_CTL), MISC + 8);
#ifndef NO_PRO
    prologue(P, lds, lane, wave);
#endif
    grid.sync();
    ssq_t* SSQ = (ssq_t*)(P.ws + WS_SSQ);
    bf16_t* HB = (bf16_t*)(P.ws + WS_HB); bf16_t* ACT = (bf16_t*)(P.ws + WS_ACT); bf16_t* GACT = (bf16_t*)(P.ws + WS_GACT);
    bf16_t* KVB = (bf16_t*)(P.ws + WS_KVB); bf16_t* QB = (bf16_t*)(P.ws + WS_QB); bf16_t* AO = (bf16_t*)(P.ws + WS_AO);
    const int gw = blockIdx.x * NWAVES + wave, NGW = gridDim.x * NWAVES;
    for (int step = 0; step < 28; ++step) {
        int l, k;
        int lane_s = threadIdx.x & 63, tid_s = threadIdx.x;
        asm volatile("" : "+v"(lane_s), "+v"(tid_s));
        int f = 0;
        if (step < 12) { l = step / 6; const int s = step % 6; k = (s == 0 || s == 4) ? 0 : (s == 1 || s == 5) ? 1 : (s == 2 ? 2 : 3); f = s >= 4; }
        else { const int s2 = step - 12; l = 2 + s2 / 8; const int s = s2 % 8; k = (s == 0 || s == 6) ? 0 : (s == 1 || s == 7) ? 1 : (s + 2); f = s >= 6; }
        if (k == 0 || k == 1 || k == 3 || k == 4 || k == 7) {
            Epi E; E.mode = EP_UP; E.nkv = 0; E.ssq_in = SSQ; E.ssq_out = SSQ; E.obf = HB; E.kvb = KVB; E.h = P.out; E.base_p = P.out; E.base_s = P.out + (size_t)MP * D; E.bias = P.in[25]; E.out = P.out; E.scale = 1.0f;
            pg8::Gemm g; g.M = MP; const bf16_t* As;
            if (k == 0) { const int i = 2 * l + f; E.mode = EP_UP; E.nkv = (l == 2 && f == 0) ? 12 : 0; E.ssq_in = SSQ + (size_t)(f ? 3 * l + 2 : 3 * l) * SSQ_STRIDE; E.obf = ACT;
                g.A = HB; g.Bt = E.nkv ? wkv_ptr(P.ws) : wup_ptr(P.ws, i); g.N = 2 * FF + E.nkv * 256; g.K = D; As = HB + (size_t)MP * D; }
            else if (k == 1) { const int i = 2 * l + f; E.mode = EP_RES; E.scale = 0.5f; if (l == 0 && f == 0) { E.base_p = P.in[0]; E.base_s = P.in[1]; }
                E.ssq_out = SSQ + (size_t)(f ? 3 * l + 3 : 3 * l + 1) * SSQ_STRIDE; E.obf = HB;
                g.A = ACT; g.Bt = (const bf16_t*)(P.ws + WS_WDN + (size_t)i * SZ_DN); g.N = D; g.K = FF; As = ACT + (size_t)MP * FF; }
            else if (k == 3) { E.mode = EP_GLU; E.bias = P.in[25] + l * 2 * D; E.ssq_out = SSQ + (size_t)(3 * l + 2) * SSQ_STRIDE; E.obf = HB;
                g.A = GACT; g.Bt = (const bf16_t*)(P.ws + WS_WGLU + (size_t)l * SZ_GLU); g.N = 2 * D; g.K = D; As = GACT + (size_t)MP * D; }
            else if (k == 4) { E.mode = EP_Q; E.ssq_in = SSQ + (size_t)(3 * l + 1) * SSQ_STRIDE; E.obf = QB;
                g.A = HB; g.Bt = (const bf16_t*)(P.ws + WS_WQ + (size_t)(l - 2) * SZ_Q); g.N = NQC; g.K = D; As = HB + (size_t)MP * D; }
            else { E.mode = EP_RES; E.scale = 1.0f; E.ssq_out = SSQ + (size_t)(3 * l + 2) * SSQ_STRIDE; E.obf = HB;
                g.A = AO; g.Bt = (const bf16_t*)(P.ws + WS_WO + (size_t)(l - 2) * SZ_O); g.N = D; g.K = AW; As = AO + (size_t)MP * AW; }
#ifndef NO_SG
            small_gemm(E, As, g.Bt, g.K, lane_s, wave);
#endif
            pg8::StaticOrder S; S.init(g.M, g.N, (int)gridDim.x, (int)blockIdx.x);
#ifndef NO_GEMM
            pg8::gemm_phase<Epi, pg8::StaticOrder>(lds, g, S, E);
#endif
        } else if (k == 2) {
            const ssq_t* ssq = SSQ + (size_t)(3 * l + 1) * SSQ_STRIDE;
#ifndef NO_SSMS
            for (int it = blockIdx.x + gridDim.x * wave; it < NSMP * 64; it += NGW) ssm_sample_item(P, l, it, lane_s, ssq);
#endif
#ifndef NO_SSMP
            ssm_prompt(P, l, lds, ssq, tid_s, lane_s, wave);
#endif
        } else if (k == 5) {
#ifndef NO_ATTS
            for (int it = blockIdx.x + gridDim.x * wave; it < NSMP * 8; it += NGW) attn_sample_item(P, it, lane_s, (LAS float*)(lds + wave * 4096));
#endif
            for (int id = gw; id < 64 * 128; id += NGW) { const int bh = id >> 7, r = id & 127, g = 1 + (r >> 6), r2 = r & 63; const int rho = (g == 1) ? (r2 >> 4) : (r2 >> 2), itile = (g == 1) ? (r2 & 15) : (r2 & 3);
#ifndef NO_ATT
                attn_tile(P, bh >> 3, bh & 7, g, rho, 32 * itile, lane_s, false);
#endif
 }
        } else {
            for (int id = gw; id < 64 * 64; id += NGW) { const int bh = id >> 6, itile = id & 63;
#ifndef NO_ATT
 attn_tile(P, bh >> 3, bh & 7, 0, 0, 32 * itile, lane_s, true);
#endif
 }
        }
        xcd_barrier(bar);
    }
    final_norm(P, lane, wave);
}

extern "C" void kernel_launch(void* const* d_in, const int* in_sizes, int n_in, void* d_out, int out_size, void* d_ws, size_t ws_size, hipStream_t stream) {
    static int grid = 0;
    if (grid == 0) {
        if (n_in != 29 || (size_t)out_size != O_END || ws_size < WS_END) { fprintf(stderr, "kernel_launch: unexpected shapes (n_in %d, out %d, ws %zu; need 29, %zu, >= %zu)\n", n_in, out_size, ws_size, (size_t)O_END, (size_t)WS_END); grid = -1; return; }
        int dev = 0, cus = 0, per_cu = 0;
        if (hipGetDevice(&dev) != hipSuccess || hipDeviceGetAttribute(&cus, hipDeviceAttributeMultiprocessorCount, dev) != hipSuccess) { grid = -1; return; }
        if (hipFuncSetAttribute((const void*)yoco_fwd, hipFuncAttributeMaxDynamicSharedMemorySize, LDS_BYTES) != hipSuccess) { fprintf(stderr, "kernel_launch: hipFuncSetAttribute failed\n"); grid = -1; return; }
        if (hipOccupancyMaxActiveBlocksPerMultiprocessor(&per_cu, (const void*)yoco_fwd, NTHREADS, LDS_BYTES) != hipSuccess || per_cu < 1) { fprintf(stderr, "kernel_launch: occupancy query says %d\n", per_cu); per_cu = 1; }
        (void)hipGetLastError();
        grid = cus;
    }
    if (grid < 0) return;
    (void)hipMemsetAsync((char*)d_ws + WS_CTL, 0, CTL_BYTES, stream);
    Params p{};
    for (int i = 0; i < 29; ++i) p.in[i] = (const float*)d_in[i];
    p.out = (float*)d_out; p.ws = (unsigned char*)d_ws;
    void* args[] = {&p};
    hipError_t e = hipLaunchCooperativeKernel((const void*)yoco_fwd, dim3(grid), dim3(NTHREADS), args, LDS_BYTES, stream);
    if (e != hipSuccess) fprintf(stderr, "kernel_launch: cooperative launch failed: %s (grid %d)\n", hipGetErrorString(e), grid);
}
```

```cpp
#include <hip/hip_runtime.h>
#include <hip/hip_cooperative_groups.h>
#include <cstdio>
namespace cg = cooperative_groups;


#define LAS __attribute__((address_space(3)))
typedef short s16x4 __attribute__((ext_vector_type(4)));
typedef float f32x2 __attribute__((ext_vector_type(2)));
typedef float f32x16 __attribute__((ext_vector_type(16)));
typedef unsigned u32x2 __attribute__((ext_vector_type(2)));
typedef __bf16 bf16x2_t __attribute__((ext_vector_type(2)));

namespace pg8 {
#define PG8_LAS __attribute__((address_space(3)))
typedef unsigned short bf16_t;
typedef short bf16x8 __attribute__((ext_vector_type(8)));
typedef float f32x4 __attribute__((ext_vector_type(4)));
typedef unsigned u32x4 __attribute__((ext_vector_type(4)));
constexpr int BM = 256, BK = 64, HALF = 128, HTB = HALF * BK * 2  , STAGE_BYTES = 8 * HTB, NXCD = 8, WGM = 8;

__host__ __device__ __forceinline__ int lds_byte(int r, int c) { const int st = (r >> 4) * 2 + (c >> 5), rr = r & 15, cc = c & 31, ob = rr * 64 + cc * 2; return st * 1024 + (ob ^ (((ob >> 9) & 1) << 5)); }
__host__ __device__ __forceinline__ void stage_rc(int b, int& R, int& C) { const int st = b / 1024, sb = b % 1024, swz = sb ^ (((sb >> 9) & 1) << 5); R = (st >> 1) * 16 + swz / 64; C = (st & 1) * 32 + (swz % 64) / 2; }
__host__ __device__ __forceinline__ int perm32(int rho) { const int n = rho >> 4, i = rho & 15; return 8 * (i >> 2) + 4 * n + (i & 3); }

struct Unit { int pm, pn; };
struct Gemm { const bf16_t* A; const bf16_t* Bt; int M, N, K; };

struct StaticOrder {
    int nM, nN, nwg, G, c;
    __host__ __device__ void init(int M, int N, int G_, int c_) { nM = M / BM; nN = N / BM; nwg = nM * nN; G = G_; c = c_; }
    __host__ __device__ bool next(int i, Unit& u) const {
        const long L = (long)i * G + c; if (L >= nwg) return false;
        int wgid = (int)L; { const int q = nwg / NXCD, r = nwg % NXCD, xcd = wgid % NXCD, off = wgid / NXCD; wgid = (xcd < r ? xcd * (q + 1) : r * (q + 1) + (xcd - r) * q) + off; }
        const int nig = WGM * nN, gid = wgid / nig, fm = gid * WGM, gsz = (nM - fm) < WGM ? (nM - fm) : WGM;
        u.pm = fm + ((wgid % nig) % gsz); u.pn = (wgid % nig) / gsz; return true;
    }
    __device__ __forceinline__ void a_ready(const Unit&) const {}
    __device__ __forceinline__ void done(const Unit&) const {}
};
template <class Epi, class Sched>
__device__ __forceinline__ void gemm_phase(PG8_LAS unsigned char* lds, const Gemm g, const Sched& S, const Epi& E) {
    const int tid = threadIdx.x, wid = __builtin_amdgcn_readfirstlane(tid >> 6), lane = tid & 63, wr = wid >> 2, wc = wid & 3, fr = lane & 15, fq = lane >> 4;
    const int K = g.K, nt = K / BK;
    unsigned voffA[2], voffB[2];
#pragma unroll
    for (int i = 0; i < 2; ++i) { int R, C; stage_rc(tid * 16 + i * 8192, R, C); const int Rb = Epi::PERM ? ((R & ~31) + perm32(R & 31)) : R;
        voffA[i] = (unsigned)(R * K + C) * 2u; voffB[i] = (unsigned)(Rb * K + C) * 2u; }
    const size_t kstep = (size_t)(BK * 2);
    const size_t hstep = (size_t)HALF * K * 2;
    const size_t tstep = 2 * hstep;
    const unsigned ldsw = (unsigned)wid * 1024u;
    const int aoff = lds_byte(wr * 64 + fr, fq * 8), boff = lds_byte(wc * 32 + fr, fq * 8);
#define PG8_SA(b, h) (((b) * 2 + (h)) * HTB)
#define PG8_SB(b, h) ((4 + (b) * 2 + (h)) * HTB)
#define PG8_STAGE(bufoff, gbase, voff) do { _Pragma("unroll") for (int _i = 0; _i < 2; ++_i) \
        __builtin_amdgcn_global_load_lds((const unsigned*)((const char*)(gbase) + (voff)[_i]), (PG8_LAS unsigned*)(lds + (bufoff) + ldsw + _i * 8192), 16, 0, 0); } while (0)
#define PG8_LDA(dst, b, h) do { _Pragma("unroll") for (int m = 0; m < 4; ++m) _Pragma("unroll") for (int k = 0; k < 2; ++k) dst[m][k] = *(const PG8_LAS bf16x8*)(lds + PG8_SA(b, h) + aoff + m * 2048 + k * 1024); } while (0)
#define PG8_LDB(dst, b, h) do { _Pragma("unroll") for (int n = 0; n < 2; ++n) _Pragma("unroll") for (int k = 0; k < 2; ++k) dst[n][k] = *(const PG8_LAS bf16x8*)(lds + PG8_SB(b, h) + boff + n * 2048 + k * 1024); } while (0)
#define PG8_MMA(ai, bj, At, Bt) do { __builtin_amdgcn_s_setprio(1); _Pragma("unroll") for (int m = 0; m < 4; ++m) _Pragma("unroll") for (int n = 0; n < 2; ++n) _Pragma("unroll") for (int k = 0; k < 2; ++k) \
        acc[ai][bj][m][n] = __builtin_amdgcn_mfma_f32_16x16x32_bf16(Bt[n][k], At[m][k], acc[ai][bj][m][n], 0, 0, 0); __builtin_amdgcn_s_setprio(0); } while (0)
#define PG8_WAIT_V(n) asm volatile("s_waitcnt vmcnt(" #n ")" ::: "memory")
#define PG8_WAIT_L(n) asm volatile("s_waitcnt lgkmcnt(" #n ")" ::: "memory")
#define PG8_BAR __builtin_amdgcn_s_barrier()
#define PG8_SCHED __builtin_amdgcn_sched_barrier(0)
    Unit cur, nxt; int ui = 0;
    if (!S.next(0, cur)) return;
    f32x4 acc[2][2][4][2];
#pragma unroll
    for (int a = 0; a < 2; ++a)
#pragma unroll
        for (int b = 0; b < 2; ++b)
#pragma unroll
            for (int m = 0; m < 4; ++m)
#pragma unroll
                for (int n = 0; n < 2; ++n) acc[a][b][m][n] = (f32x4){0.f, 0.f, 0.f, 0.f};
    bf16x8 At[4][2], B0[2][2], B1[2][2];
    const char* cA = (const char*)g.A + (size_t)cur.pm * tstep; const char* cB = (const char*)g.Bt + (size_t)cur.pn * tstep;
    S.a_ready(cur);
    PG8_STAGE(PG8_SB(0, 0), cB, voffB); PG8_STAGE(PG8_SA(0, 0), cA, voffA); PG8_STAGE(PG8_SB(0, 1), cB + hstep, voffB); PG8_STAGE(PG8_SA(0, 1), cA + hstep, voffA);
    if (wr == 1) PG8_BAR;
    PG8_WAIT_V(4); PG8_BAR;
    PG8_STAGE(PG8_SB(1, 0), cB + kstep, voffB); PG8_STAGE(PG8_SA(1, 0), cA + kstep, voffA); PG8_STAGE(PG8_SB(1, 1), cB + hstep + kstep, voffB);
    PG8_WAIT_V(6); PG8_BAR;
    for (;;) {
        const bool has_next = S.next(ui + 1, nxt);
        const char* nA = has_next ? (const char*)g.A + (size_t)nxt.pm * tstep : cA; const char* nB = has_next ? (const char*)g.Bt + (size_t)nxt.pn * tstep : cB;
        for (int t = 0; t < nt; t += 2) {
            const bool last = (t == nt - 2);
            const char* a1 = cA + (size_t)(t + 1) * kstep;
            const char* a2 = last ? nA : cA + (size_t)(t + 2) * kstep; const char* b2 = last ? nB : cB + (size_t)(t + 2) * kstep;
            const char* a3 = a2 + kstep; const char* b3 = b2 + kstep;
            if (last && has_next) S.a_ready(nxt);
            PG8_LDB(B0, 0, 0); PG8_SCHED; PG8_LDA(At, 0, 0); PG8_STAGE(PG8_SA(1, 1), a1 + hstep, voffA);
            PG8_WAIT_L(8); PG8_BAR; PG8_WAIT_L(0); PG8_MMA(0, 0, At, B0); PG8_BAR; PG8_SCHED;
            PG8_LDB(B1, 0, 1); PG8_STAGE(PG8_SB(0, 0), b2, voffB);
            PG8_BAR; PG8_WAIT_L(0); PG8_MMA(0, 1, At, B1); PG8_BAR;
            PG8_LDA(At, 0, 1); PG8_STAGE(PG8_SA(0, 0), a2, voffA);
            PG8_BAR; PG8_WAIT_L(0); PG8_MMA(1, 0, At, B0); PG8_BAR; PG8_SCHED;
            PG8_STAGE(PG8_SB(0, 1), b2 + hstep, voffB);
            PG8_WAIT_V(6); PG8_BAR; PG8_MMA(1, 1, At, B1); PG8_BAR;
            PG8_LDB(B0, 1, 0); PG8_SCHED; PG8_LDA(At, 1, 0); PG8_STAGE(PG8_SA(0, 1), a2 + hstep, voffA);
            PG8_WAIT_L(8); PG8_BAR; PG8_WAIT_L(0); PG8_MMA(0, 0, At, B0); PG8_BAR; PG8_SCHED;
            PG8_LDB(B1, 1, 1); PG8_STAGE(PG8_SB(1, 0), b3, voffB);
            PG8_BAR; PG8_WAIT_L(0); PG8_MMA(0, 1, At, B1); PG8_BAR;
            PG8_LDA(At, 1, 1); PG8_STAGE(PG8_SA(1, 0), a3, voffA);
            PG8_BAR; PG8_WAIT_L(0); PG8_MMA(1, 0, At, B0); PG8_BAR; PG8_SCHED;
            PG8_STAGE(PG8_SB(1, 1), b3 + hstep, voffB);
            PG8_WAIT_V(6); PG8_BAR; PG8_MMA(1, 1, At, B1); PG8_BAR;
        }
        if constexpr (!Epi::AFTER_DRAIN) { E(acc, cur, wr, wc, fr, fq); S.done(cur); }
        if (!has_next) break;
#pragma unroll
        for (int a = 0; a < 2; ++a)
#pragma unroll
            for (int b = 0; b < 2; ++b)
#pragma unroll
                for (int m = 0; m < 4; ++m)
#pragma unroll
                    for (int n = 0; n < 2; ++n) acc[a][b][m][n] = (f32x4){0.f, 0.f, 0.f, 0.f};
        cur = nxt; cA = nA; cB = nB; ++ui;
    }
    PG8_WAIT_V(0);
    if (wr == 0) PG8_BAR;
    PG8_BAR;
    if constexpr (Epi::AFTER_DRAIN) { E.fused(acc, cur, wr, wc, fr, fq, lds, wid, lane); S.done(cur); }
#undef PG8_SA
#undef PG8_SB
#undef PG8_STAGE
#undef PG8_LDA
#undef PG8_LDB
#undef PG8_MMA
#undef PG8_WAIT_V
#undef PG8_WAIT_L
#undef PG8_BAR
#undef PG8_SCHED
}
}

using pg8::bf16_t; using pg8::bf16x8; using pg8::f32x4; using pg8::u32x4;

constexpr int D = 1024, SEQ = 2048, NBATCH = 8, MP = NBATCH * SEQ, NSMP = 32, MT = MP + NSMP, FF = 2816, NKVC = 3072, NQC = 1536, AW = 512;
constexpr int NWAVES = 8, NTHREADS = 512;
constexpr float EPS = 1e-6f;
constexpr int SSQ_STRIDE = 16640;
constexpr size_t O_Y = 0, O_YS = (size_t)MP * D, O_SRP = O_YS + (size_t)NSMP * D, O_SIP = O_SRP + 65536, O_KV128 = O_SIP + 65536,
                 O_KV512 = O_KV128 + (size_t)8 * 128 * 1024, O_KV2048 = O_KV512 + (size_t)8 * 512 * 1024, O_SRS = O_KV2048 + (size_t)8 * 2048 * 1024,
                 O_SIS = O_SRS + 262144, O_KVS128 = O_SIS + 262144, O_KVS512 = O_KVS128 + 32768, O_KVS2048 = O_KVS512 + 32768, O_END = O_KVS2048 + 32768;
constexpr size_t al256(size_t x) { return (x + 255) & ~(size_t)255; }
constexpr size_t SZ_UP = (size_t)2 * FF * D * 2, SZ_DN = (size_t)D * FF * 2, SZ_GLU = (size_t)2 * D * D * 2, SZ_Q = (size_t)NQC * D * 2, SZ_KV = (size_t)NKVC * D * 2, SZ_O = (size_t)D * AW * 2;
constexpr size_t WS_CTL = 0, CTL_BYTES = 65536;
constexpr size_t WS_SSQ = CTL_BYTES;
constexpr size_t WS_WUP = al256(WS_SSQ + (size_t)13 * SSQ_STRIDE * 8);
constexpr size_t WS_WDN = WS_WUP + 8 * SZ_UP + SZ_KV;
constexpr size_t WS_WGLU = WS_WDN + 8 * SZ_DN;
constexpr size_t WS_WQ = WS_WGLU + 2 * SZ_GLU;
constexpr size_t WS_WO = WS_WQ + 2 * SZ_Q;
constexpr size_t WS_HB = WS_WO + 2 * SZ_O;
constexpr size_t WS_ACT = al256(WS_HB + (size_t)MT * D * 2);
constexpr size_t WS_GACT = al256(WS_ACT + (size_t)MT * FF * 2);
constexpr size_t WS_KVB = al256(WS_GACT + (size_t)MT * D * 2);
constexpr size_t WS_QB = al256(WS_KVB + (size_t)MT * NKVC * 2);
constexpr size_t WS_AO = al256(WS_QB + (size_t)MT * NQC * 2);
constexpr size_t WS_PO = al256(WS_AO + (size_t)MT * AW * 2);
constexpr size_t WS_PM = al256(WS_PO + (size_t)2 * MP * AW * 2);
constexpr size_t WS_PL = al256(WS_PM + (size_t)2 * MP * 8 * 4);
constexpr size_t WS_END = al256(WS_PL + (size_t)2 * MP * 8 * 4);
constexpr int LDS_BYTES = 163840;

struct Params { const float* in[29]; float* out; unsigned char* ws; };

#define LDS_WAIT() asm volatile("s_waitcnt lgkmcnt(0)" ::: "memory")
__device__ __forceinline__ unsigned pk_bf16(float lo, float hi) { f32x2 v = {lo, hi}; return __builtin_bit_cast(unsigned, __builtin_convertvector(v, bf16x2_t)); }
__device__ __forceinline__ float bf2f(unsigned short b) { return __uint_as_float(((unsigned)b) << 16); }
__device__ __forceinline__ unsigned short f2bf(float f) { return (unsigned short)(pk_bf16(f, 0.f) & 0xffffu); }
__device__ __forceinline__ void st_bf16x4(bf16_t* p, f32x4 v) { u32x2 w; w.x = pk_bf16(v[0], v[1]); w.y = pk_bf16(v[2], v[3]); *(u32x2*)p = w; }
__device__ __forceinline__ float sigm_f(float a) { return __builtin_amdgcn_rcpf(1.0f + __expf(-a)); }
__device__ __forceinline__ float silu_f(float a) { return a * sigm_f(a); }
__device__ __forceinline__ float gelu_tanh_f(float y) { return y * sigm_f(1.5957691216f * (y + 0.044715f * y * y * y)); }
typedef unsigned long long ssq_t;
__device__ __forceinline__ ssq_t ssq_fix(float ss) { return (ssq_t)(ss * 1048576.0f + 0.5f); }
__device__ __forceinline__ float rstd_of(const ssq_t* ssq, int row) { return 1.0f / sqrtf((float)ssq[row] * (1.0f / (1048576.0f * 1024.0f)) + EPS); }
__device__ __forceinline__ float wave_sum(float v) {
#pragma unroll
    for (int o = 1; o < 64; o <<= 1) v += __shfl_xor(v, o);
    return v;
}
__device__ __forceinline__ float wave_max(float v) {
#pragma unroll
    for (int o = 1; o < 64; o <<= 1) v = fmaxf(v, __shfl_xor(v, o));
    return v;
}
__device__ __forceinline__ int crow(int i, int h) { return (i & 3) + 8 * (i >> 2) + 4 * h; }

#define XB_TMO      128
#define XB_XCNT(j)  (256  + 64 * (j))
#define XB_XSUB(j)  (1280 + 64 * (j))
#define XB_XGEN(j)  (2304 + 64 * (j))
#define XB_TOP      3328
#define XB_TOPGEN   3392
#define XCD_BAR_WORDS 3456
#define XB_SPIN_CAP (1u << 18)

__device__ __forceinline__ unsigned xb_ld(unsigned* p)              { return __hip_atomic_load(p, __ATOMIC_RELAXED, __HIP_MEMORY_SCOPE_AGENT); }
__device__ __forceinline__ unsigned xb_add(unsigned* p, unsigned v) { return __hip_atomic_fetch_add(p, v, __ATOMIC_RELAXED, __HIP_MEMORY_SCOPE_AGENT); }
__device__ __forceinline__ unsigned xb_xcc_id() { return (unsigned)__builtin_amdgcn_s_getreg((3 << 11) | 20) & 0xFu; }
#define XB_SPIN(cond, bar) do { unsigned _sp = 0; while (cond) { __builtin_amdgcn_s_sleep(1); \
    if ((++_sp & 255u) == 0u) { if (xb_ld(&(bar)[XB_TMO])) break; if (_sp > XB_SPIN_CAP) { atomicAdd(&(bar)[XB_TMO], 1u); break; } } } } while (0)

struct XcdBarrier {
    unsigned* bar; unsigned x;
    volatile LAS unsigned* st;
};

__device__ __forceinline__ XcdBarrier xcd_barrier_post(unsigned* bar, volatile LAS unsigned* st) {
    XcdBarrier b; b.bar = bar; b.x = xb_xcc_id(); b.st = st;
    if (threadIdx.x == 0) (void)xb_add(&bar[XB_XCNT(b.x)], 1u);
    return b;
}
__device__ __forceinline__ void xcd_barrier_complete(unsigned* bar, unsigned x, unsigned& nloc, unsigned& nx) {
    const unsigned G = gridDim.x * gridDim.y * gridDim.z;
    unsigned sum, cnt, mine, sp = 0u;
    for (;;) {
        sum = 0u; cnt = 0u; mine = 0u;
#pragma unroll
        for (unsigned j = 0; j < 16; ++j) { const unsigned c = xb_ld(&bar[XB_XCNT(j)]); sum += c; cnt += (c > 0u) ? 1u : 0u; mine = (j == x) ? c : mine; }
        if (sum == G) break;
        __builtin_amdgcn_s_sleep(1);
        if ((++sp & 255u) == 0u) { if (xb_ld(&bar[XB_TMO])) break; if (sp > XB_SPIN_CAP) { atomicAdd(&bar[XB_TMO], 1u); break; } }
    }
    nloc = mine > 0u ? mine : 1u; nx = cnt > 0u ? cnt : 1u;
}

__device__ __forceinline__ void xcd_barrier(const XcdBarrier& b) {
    asm volatile("s_waitcnt vmcnt(0)" ::: "memory");
    __syncthreads();
    if (threadIdx.x == 0) {
        unsigned* bar = b.bar;
        __builtin_amdgcn_s_waitcnt(0);
        unsigned nloc = b.st[0], nx = b.st[1];
        if (nloc == 0u) { xcd_barrier_complete(bar, b.x, nloc, nx); b.st[0] = nloc; b.st[1] = nx; }
        const unsigned old = xb_add(&bar[XB_XSUB(b.x)], 1u);
        const unsigned gen = old / nloc;
        if (old + 1u == (gen + 1u) * nloc) {
            __builtin_amdgcn_fence(__ATOMIC_RELEASE, "agent");
            asm volatile("s_waitcnt vmcnt(0)" ::: "memory");
            const unsigned og = xb_add(&bar[XB_TOP], 1u);
            const unsigned tg = og / nx;
            if (og + 1u == (tg + 1u) * nx) xb_add(&bar[XB_TOPGEN], 1u);
            else XB_SPIN(xb_ld(&bar[XB_TOPGEN]) == tg, bar);
            __builtin_amdgcn_fence(__ATOMIC_ACQUIRE, "agent");
            xb_add(&bar[XB_XGEN(b.x)], 1u);
            asm volatile("s_waitcnt vmcnt(0)" ::: "memory");
        } else {
            XB_SPIN(xb_ld(&bar[XB_XGEN(b.x)]) == gen, bar);
            __builtin_amdgcn_fence(__ATOMIC_ACQUIRE, "agent");
            asm volatile("s_waitcnt vmcnt(0)" ::: "memory");
        }
    }
    __syncthreads();
}

enum { EP_UP = 0, EP_RES = 1, EP_GLU = 2, EP_Q = 3 };
struct Epi {
    static constexpr bool PERM = false, AFTER_DRAIN = false;
    int mode, nkv;
    const ssq_t* ssq_in;
    ssq_t* ssq_out;
    bf16_t* obf;
    bf16_t* kvb;
    float* h;
    const float* base_p;
    const float* base_s;
    const float* bias;
    float* out;
    float scale;

    __device__ __forceinline__ void el_up(int row, int fcol, f32x4 a, f32x4 b, float rs) const {
        f32x4 v;
#pragma unroll
        for (int j = 0; j < 4; ++j) v[j] = silu_f(a[j] * rs) * (b[j] * rs);
        st_bf16x4(obf + (size_t)row * FF + fcol, v);
    }
    __device__ __forceinline__ void el_kv(int row, int c, f32x4 a, float rs) const {
        const f32x4 v = a * rs;
        st_bf16x4(kvb + (size_t)row * NKVC + c, v);
        const int g = c >> 10, rem = c & 1023;
        if (row < MP) {
            const int b = row >> 11, t = row & 2047, Wg = 128 << (2 * g), t0 = SEQ - Wg;
            if (t >= t0) { float* o = out + (g == 0 ? O_KV128 : (g == 1 ? O_KV512 : O_KV2048)) + ((size_t)(b * Wg + t - t0)) * 1024 + rem; *(f32x4*)o = v; }
        } else {
            float* o = out + (g == 0 ? O_KVS128 : (g == 1 ? O_KVS512 : O_KVS2048)) + (size_t)(row - MP) * 1024 + rem; *(f32x4*)o = v;
        }
    }
    __device__ __forceinline__ float el_res(int row, int col, f32x4 a) const {
        const float* bp = (row < MP) ? base_p + (size_t)row * D + col : base_s + (size_t)(row - MP) * D + col;
        const f32x4 v = *(const f32x4*)bp + scale * a;
        *(f32x4*)(h + (size_t)row * D + col) = v;
        st_bf16x4(obf + (size_t)row * D + col, v);
        return (v[0] * v[0] + v[1] * v[1]) + (v[2] * v[2] + v[3] * v[3]);
    }
    __device__ __forceinline__ float el_glu(int row, int col, f32x4 a, f32x4 b) const {
        const f32x4 b1 = *(const f32x4*)(bias + col), b2 = *(const f32x4*)(bias + D + col);
        const f32x4 hv = *(const f32x4*)(h + (size_t)row * D + col);
        f32x4 v;
#pragma unroll
        for (int j = 0; j < 4; ++j) v[j] = hv[j] + (a[j] + b1[j]) * sigm_f(b[j] + b2[j]);
        *(f32x4*)(h + (size_t)row * D + col) = v;
        st_bf16x4(obf + (size_t)row * D + col, v);
        return (v[0] * v[0] + v[1] * v[1]) + (v[2] * v[2] + v[3] * v[3]);
    }
    __device__ __forceinline__ void el_q(int row, int c, f32x4 a, float rs) const {
        const f32x4 v = a * (rs * 0.125f);
        st_bf16x4(obf + (size_t)row * NQC + c, v);
    }
    __device__ __forceinline__ void ssq_add(int row, float ss, int fq) const {
        ss += __shfl_xor(ss, 16); ss += __shfl_xor(ss, 32);
        if (fq == 0) atomicAdd(ssq_out + row, ssq_fix(ss));
    }
    __device__ __forceinline__ void operator()(const f32x4 (&acc)[2][2][4][2], const pg8::Unit& u, int wr, int wc, int fr, int fq) const {
        const int row0 = u.pm * 256 + wr * 64 + fr;
        if (mode == EP_UP || mode == EP_Q) {
            float rs[2][4];
#pragma unroll
            for (int ai = 0; ai < 2; ++ai)
#pragma unroll
                for (int m = 0; m < 4; ++m) rs[ai][m] = rstd_of(ssq_in, row0 + ai * 128 + m * 16);
            if (mode == EP_Q) {
                const int c0 = u.pn * 256 + wc * 32 + 4 * fq;
#pragma unroll
                for (int ai = 0; ai < 2; ++ai)
#pragma unroll
                    for (int m = 0; m < 4; ++m) { const int row = row0 + ai * 128 + m * 16;
#pragma unroll
                        for (int bj = 0; bj < 2; ++bj)
#pragma unroll
                            for (int n = 0; n < 2; ++n) el_q(row, c0 + bj * 128 + n * 16, acc[ai][bj][m][n], rs[ai][m]); }
            } else if (u.pn >= nkv) {
                const int f0 = (u.pn - nkv) * 128 + wc * 32 + 4 * fq;
#ifndef REP_EPI
#define REP_EPI 1
#endif
                for (int rep = 0; rep < REP_EPI; ++rep)
#pragma unroll
                for (int ai = 0; ai < 2; ++ai)
#pragma unroll
                    for (int m = 0; m < 4; ++m) { const int row = row0 + ai * 128 + m * 16;
#pragma unroll
                        for (int n = 0; n < 2; ++n) el_up(row, f0 + n * 16, acc[ai][0][m][n], acc[ai][1][m][n], rs[ai][m]); }
            } else {
                const int c0 = u.pn * 256 + wc * 32 + 4 * fq;
#pragma unroll
                for (int ai = 0; ai < 2; ++ai)
#pragma unroll
                    for (int m = 0; m < 4; ++m) { const int row = row0 + ai * 128 + m * 16;
#pragma unroll
                        for (int bj = 0; bj < 2; ++bj)
#pragma unroll
                            for (int n = 0; n < 2; ++n) el_kv(row, c0 + bj * 128 + n * 16, acc[ai][bj][m][n], rs[ai][m]); }
            }
        } else if (mode == EP_RES) {
            const int c0 = u.pn * 256 + wc * 32 + 4 * fq;
#pragma unroll
            for (int ai = 0; ai < 2; ++ai)
#pragma unroll
              for (int mh = 0; mh < 2; ++mh) {
                f32x4 bv[2][2][2];
#pragma unroll
                for (int m = 0; m < 2; ++m)
#pragma unroll
                    for (int bj = 0; bj < 2; ++bj)
#pragma unroll
                        for (int n = 0; n < 2; ++n) bv[m][bj][n] = *(const f32x4*)(base_p + (size_t)(row0 + ai * 128 + (2 * mh + m) * 16) * D + c0 + bj * 128 + n * 16);
#pragma unroll
                for (int m = 0; m < 2; ++m) { const int row = row0 + ai * 128 + (2 * mh + m) * 16; float ss = 0.f;
#pragma unroll
                    for (int bj = 0; bj < 2; ++bj)
#pragma unroll
                        for (int n = 0; n < 2; ++n) { const int col = c0 + bj * 128 + n * 16; const f32x4 v = bv[m][bj][n] + scale * acc[ai][bj][2 * mh + m][n];
                            *(f32x4*)(h + (size_t)row * D + col) = v; st_bf16x4(obf + (size_t)row * D + col, v); ss += (v[0] * v[0] + v[1] * v[1]) + (v[2] * v[2] + v[3] * v[3]); }
                    ssq_add(row, ss, fq); }
              }
        } else {
            const int c0 = u.pn * 128 + wc * 32 + 4 * fq;
            f32x4 b1[2], b2[2];
#pragma unroll
            for (int n = 0; n < 2; ++n) { b1[n] = *(const f32x4*)(bias + c0 + n * 16); b2[n] = *(const f32x4*)(bias + D + c0 + n * 16); }
#pragma unroll
            for (int ai = 0; ai < 2; ++ai) {
                f32x4 hv[4][2];
#pragma unroll
                for (int m = 0; m < 4; ++m)
#pragma unroll
                    for (int n = 0; n < 2; ++n) hv[m][n] = *(const f32x4*)(h + (size_t)(row0 + ai * 128 + m * 16) * D + c0 + n * 16);
#pragma unroll
                for (int m = 0; m < 4; ++m) { const int row = row0 + ai * 128 + m * 16; float ss = 0.f;
#pragma unroll
                    for (int n = 0; n < 2; ++n) { const int col = c0 + n * 16; f32x4 v;
#pragma unroll
                        for (int j = 0; j < 4; ++j) v[j] = hv[m][n][j] + (acc[ai][0][m][n][j] + b1[n][j]) * sigm_f(acc[ai][1][m][n][j] + b2[n][j]);
                        *(f32x4*)(h + (size_t)row * D + col) = v; st_bf16x4(obf + (size_t)row * D + col, v); ss += (v[0] * v[0] + v[1] * v[1]) + (v[2] * v[2] + v[3] * v[3]); }
                    ssq_add(row, ss, fq); }
            }
        }
    }
};

__device__ __forceinline__ void small_gemm(const Epi& E, const bf16_t* A  , const bf16_t* Bt, int K, int lane, int wave, LAS unsigned char* lds) {
    const int r16 = lane & 15, q4 = lane >> 4;
    LAS f32x4* red = (LAS f32x4*)lds;
    int nitems;
    if (E.mode == EP_UP) nitems = 176 + E.nkv * 16; else if (E.mode == EP_Q) nitems = 96; else nitems = 64;
    const int kper = K >> 3, kbeg = wave * kper;
    for (int it = (int)(gridDim.x - 1 - blockIdx.x); it < nitems; it += gridDim.x) {
        int n0 = 0, n1 = 0, ocol = 0; bool kvstrip = false;
        if (E.mode == EP_UP) {
            if (it < E.nkv * 16) { kvstrip = true; n0 = 16 * it; n1 = n0; ocol = n0; }
            else { const int p = it - E.nkv * 16, pnu = p >> 3, s = p & 7; n0 = E.nkv * 256 + pnu * 256 + 16 * s; n1 = n0 + 128; ocol = pnu * 128 + 16 * s; }
        } else if (E.mode == EP_GLU) { const int pn = it >> 3, s = it & 7; n0 = pn * 256 + 16 * s; n1 = n0 + 128; ocol = pn * 128 + 16 * s; }
        else { n0 = 16 * it; n1 = n0; ocol = n0; }
        const bf16_t* a0p = A + (size_t)r16 * K + 8 * q4 + kbeg; const bf16_t* a1p = a0p + (size_t)16 * K;
        const bf16_t* b0p = Bt + (size_t)(n0 + r16) * K + 8 * q4 + kbeg; const bf16_t* b1p = Bt + (size_t)(n1 + r16) * K + 8 * q4 + kbeg;
        f32x4 acc00 = {0.f, 0.f, 0.f, 0.f}, acc01 = acc00, acc10 = acc00, acc11 = acc00;
        for (int kk = 0; kk < kper; kk += 32) {
            const bf16x8 a0 = *(const bf16x8*)(a0p + kk), a1 = *(const bf16x8*)(a1p + kk), b0 = *(const bf16x8*)(b0p + kk), b1 = *(const bf16x8*)(b1p + kk);
            acc00 = __builtin_amdgcn_mfma_f32_16x16x32_bf16(b0, a0, acc00, 0, 0, 0);
            acc01 = __builtin_amdgcn_mfma_f32_16x16x32_bf16(b0, a1, acc01, 0, 0, 0);
            acc10 = __builtin_amdgcn_mfma_f32_16x16x32_bf16(b1, a0, acc10, 0, 0, 0);
            acc11 = __builtin_amdgcn_mfma_f32_16x16x32_bf16(b1, a1, acc11, 0, 0, 0);
        }
        red[(wave * 4 + 0) * 64 + lane] = acc00; red[(wave * 4 + 1) * 64 + lane] = acc01; red[(wave * 4 + 2) * 64 + lane] = acc10; red[(wave * 4 + 3) * 64 + lane] = acc11;
        __syncthreads();
        if (wave < 2) {
            const int rt = wave; f32x4 va = {0.f, 0.f, 0.f, 0.f}, vb = va;
#pragma unroll
            for (int w2 = 0; w2 < 8; ++w2) { va += red[(w2 * 4 + rt) * 64 + lane]; vb += red[(w2 * 4 + 2 + rt) * 64 + lane]; }
            const int col = ocol + 4 * q4, row = MP + 16 * rt + r16;
            if (E.mode == EP_UP) { const float rs = rstd_of(E.ssq_in, row); if (kvstrip) E.el_kv(row, col, va, rs); else E.el_up(row, col, va, vb, rs); }
            else if (E.mode == EP_RES) { const float ss = E.el_res(row, col, va); E.ssq_add(row, ss, q4); }
            else if (E.mode == EP_GLU) { const float ss = E.el_glu(row, col, va, vb); E.ssq_add(row, ss, q4); }
            else { const float rs = rstd_of(E.ssq_in, row); E.el_q(row, col, va, rs); }
        }
        __syncthreads();
    }
}

struct MatDesc { const float* W; const float* g; bf16_t* WT; int K, N, half; };
__device__ __forceinline__ bf16_t* wup_ptr(unsigned char* ws, int i) { return (bf16_t*)(ws + WS_WUP + (size_t)i * SZ_UP + (i >= 4 ? SZ_KV : 0)); }
__device__ __forceinline__ bf16_t* wkv_ptr(unsigned char* ws) { return (bf16_t*)(ws + WS_WUP + 4 * SZ_UP); }
__device__ __forceinline__ MatDesc mat_desc(const Params& P, int mi) {
    MatDesc d;
    if (mi < 8) { const int l = mi >> 1, f = mi & 1; d.W = P.in[f ? 12 : 8] + (size_t)l * D * 2 * FF; d.g = P.in[f ? 11 : 7] + l * D; d.WT = wup_ptr(P.ws, mi); d.K = D; d.N = 2 * FF; d.half = FF; }
    else if (mi < 16) { const int i = mi - 8, l = i >> 1, f = i & 1; d.W = P.in[f ? 13 : 9] + (size_t)l * FF * D; d.g = nullptr; d.WT = (bf16_t*)(P.ws + WS_WDN + (size_t)i * SZ_DN); d.K = FF; d.N = D; d.half = 0; }
    else if (mi < 18) { const int l = mi - 16; d.W = P.in[24] + (size_t)l * D * 2 * D; d.g = nullptr; d.WT = (bf16_t*)(P.ws + WS_WGLU + (size_t)l * SZ_GLU); d.K = D; d.N = 2 * D; d.half = D; }
    else if (mi < 20) { const int b = mi - 18; d.W = P.in[26] + (size_t)b * D * NQC; d.g = P.in[10] + (2 + b) * D; d.WT = (bf16_t*)(P.ws + WS_WQ + (size_t)b * SZ_Q); d.K = D; d.N = NQC; d.half = 0; }
    else if (mi == 20) { d.W = P.in[27]; d.g = P.in[14]; d.WT = wkv_ptr(P.ws); d.K = D; d.N = NKVC; d.half = 0; }
    else { const int b = mi - 21; d.W = P.in[28] + (size_t)b * AW * D; d.g = nullptr; d.WT = (bf16_t*)(P.ws + WS_WO + (size_t)b * SZ_O); d.K = AW; d.N = D; d.half = 0; }
    return d;
}
__device__ __forceinline__ void conv_item(const MatDesc& d, LAS float* scr, int item, int lane) {
    const int nblk = d.N / 64, kb = item / nblk, nb = item % nblk, k0 = 64 * kb, n0 = 64 * nb;
    int n0p = n0;
    if (d.half) { const int second = n0 >= d.half, m = second ? n0 - d.half : n0; n0p = 256 * (m >> 7) + (second ? 128 : 0) + (m & 127); }
    const int lr = lane >> 4, lc = (lane & 15) * 4;
    f32x4 v[16];
#pragma unroll
    for (int i = 0; i < 16; ++i) v[i] = *(const f32x4*)(d.W + (size_t)(k0 + 4 * i + lr) * d.N + n0 + lc);
    if (d.g) {
#pragma unroll
        for (int i = 0; i < 16; ++i) v[i] = v[i] * d.g[k0 + 4 * i + lr];
    }
#pragma unroll
    for (int i = 0; i < 16; ++i) { LAS float* w = scr + (4 * i + lr) * 65 + lc; w[0] = v[i][0]; w[1] = v[i][1]; w[2] = v[i][2]; w[3] = v[i][3]; }
    LDS_WAIT();
    const int c = lane & 7;
#pragma unroll
    for (int j = 0; j < 8; ++j) { const int n = (lane >> 3) + 8 * j; const LAS float* s = scr + (8 * c) * 65 + n;
        u32x4 o; o.x = pk_bf16(s[0 * 65], s[1 * 65]); o.y = pk_bf16(s[2 * 65], s[3 * 65]); o.z = pk_bf16(s[4 * 65], s[5 * 65]); o.w = pk_bf16(s[6 * 65], s[7 * 65]);
        *(u32x4*)(d.WT + (size_t)(n0p + n) * d.K + k0 + 8 * c) = o; }
    LDS_WAIT();
}
__device__ __forceinline__ void prologue(const Params& P, LAS unsigned char* lds, int lane, int wave) {
    LAS float* scr = (LAS float*)(lds + wave * 16640);
    const int gw = blockIdx.x * NWAVES + wave, NGW = gridDim.x * NWAVES;
    int rot = 0;
    for (int mi = 0; mi < 23; ++mi) {
        const MatDesc d = mat_desc(P, mi);
        const int nitems = (d.K / 64) * (d.N / 64);
        int first = gw - rot; if (first < 0) first += NGW;
        for (int it = first; it < nitems; it += NGW) conv_item(d, scr, it, lane);
        rot = (rot + nitems) % NGW;
    }
    bf16_t* HB = (bf16_t*)(P.ws + WS_HB); ssq_t* SSQ = (ssq_t*)(P.ws + WS_SSQ);
    for (int row = gw; row < MT; row += NGW) {
        const float* src = row < MP ? P.in[0] + (size_t)row * D : P.in[1] + (size_t)(row - MP) * D;
        float ss = 0.f;
#pragma unroll
        for (int j = 0; j < 4; ++j) { const f32x4 v = *(const f32x4*)(src + 4 * lane + 256 * j); ss += (v[0] * v[0] + v[1] * v[1]) + (v[2] * v[2] + v[3] * v[3]); st_bf16x4(HB + (size_t)row * D + 4 * lane + 256 * j, v); }
        ss = wave_sum(ss);
        if (lane == 0) SSQ[row] = ssq_fix(ss);
    }
    for (int i = blockIdx.x * NTHREADS + threadIdx.x; i < 12 * SSQ_STRIDE; i += gridDim.x * NTHREADS) SSQ[SSQ_STRIDE + i] = 0ull;
}
__device__ __forceinline__ void final_norm(const Params& P, int lane, int wave) {
    const int gw = blockIdx.x * NWAVES + wave, NGW = gridDim.x * NWAVES;
    const ssq_t* SSQ = (const ssq_t*)(P.ws + WS_SSQ) + 12 * SSQ_STRIDE; const float* g = P.in[15];
    for (int row = gw; row < MT; row += NGW) {
        const float rs = rstd_of(SSQ, row); float* hp = P.out + (size_t)row * D;
#pragma unroll
        for (int j = 0; j < 4; ++j) { const f32x4 v = *(const f32x4*)(hp + 4 * lane + 256 * j), gv = *(const f32x4*)(g + 4 * lane + 256 * j); *(f32x4*)(hp + 4 * lane + 256 * j) = v * rs * gv; }
    }
}

#define MFMA32(a, b, c) __builtin_amdgcn_mfma_f32_32x32x16_bf16((a), (b), (c), 0, 0, 0)
__device__ __forceinline__ bf16x8 pack8(float a0, float a1, float a2, float a3, float a4, float a5, float a6, float a7) {
    u32x4 w; w.x = pk_bf16(a0, a1); w.y = pk_bf16(a2, a3); w.z = pk_bf16(a4, a5); w.w = pk_bf16(a6, a7); return __builtin_bit_cast(bf16x8, w);
}
struct Disc { float ar, ai, cr, ci, a16r, a16i; };
__device__ __forceinline__ Disc ssm_disc(const Params& P, int lg, int p) {
    Disc d; const float dt = expf(P.in[16][lg]), lr = P.in[17][lg * 64 + p], li = P.in[18][lg * 64 + p];
    const float mag = expf(lr * dt), ang = li * dt; d.ar = mag * cosf(ang); d.ai = mag * sinf(ang);
    const float den = lr * lr + li * li; d.cr = ((d.ar - 1.0f) * lr + d.ai * li) / den; d.ci = (d.ai * lr - (d.ar - 1.0f) * li) / den;
    const float mag16 = expf(lr * dt * 16.0f), ang16 = ang * 16.0f; d.a16r = mag16 * cosf(ang16); d.a16i = mag16 * sinf(ang16);
    return d;
}
__device__ __forceinline__ void ssm_sample_item(const Params& P, int layer, int item, int lane, const ssq_t* SSQ) {
    const int b = item >> 6, g = item & 63, row = MP + b, p = lane, lg = layer * 64 + g;
    const float rs = rstd_of(SSQ, row);
    const Disc dc = ssm_disc(P, lg, p);
    const float* hrow = P.out + (size_t)row * D + g * 16; const float* gm = P.in[10] + layer * D + g * 16;
    const float* brp = P.in[19] + ((size_t)lg * 64 + p) * 16; const float* bip = P.in[20] + ((size_t)lg * 64 + p) * 16;
    float bur = 0.f, bui = 0.f;
#pragma unroll
    for (int ch = 0; ch < 16; ++ch) { const float u = hrow[ch] * rs * gm[ch], br = brp[ch], bi = bip[ch]; bur += u * (dc.cr * br - dc.ci * bi); bui += u * (dc.cr * bi + dc.ci * br); }
    const size_t si = (((size_t)layer * NSMP + b) * 64 + g) * 64 + p;
    const float s0r = P.in[2][si], s0i = P.in[3][si];
    const float xr = dc.ar * s0r - dc.ai * s0i + bur, xi = dc.ar * s0i + dc.ai * s0r + bui;
    P.out[O_SRS + si] = xr; P.out[O_SIS + si] = xi;
    float myy = 0.f;
#pragma unroll
    for (int hh = 0; hh < 16; ++hh) { const float part = xr * P.in[21][((size_t)lg * 16 + hh) * 64 + p] - xi * P.in[22][((size_t)lg * 16 + hh) * 64 + p]; const float tot = wave_sum(part); if (lane == hh) myy = tot; }
    if (lane < 16) { const float u = hrow[lane] * rs * gm[lane]; const float y = myy + P.in[23][lg * 16 + lane] * u;
        ((bf16_t*)(P.ws + WS_GACT))[(size_t)row * D + g * 16 + lane] = f2bf(gelu_tanh_f(y)); }
}
__device__ __forceinline__ void ssm_prompt(const Params& P, int layer, LAS unsigned char* lds, const ssq_t* SSQ, int tid, int lane, int wave) {
    LAS float* Sre = (LAS float*)lds;
    LAS float* Sim = (LAS float*)(lds + 66560);
    LAS float* LA = (LAS float*)(lds + 133120);
    LAS float* LA16 = (LAS float*)(lds + 134144);
    LAS float* LC = (LAS float*)(lds + 135168);
    const bf16_t* HB = (const bf16_t*)(P.ws + WS_HB); bf16_t* GACT = (bf16_t*)(P.ws + WS_GACT);
    const int r = lane & 31, half = lane >> 5, it2 = wave >> 2, w4 = wave & 3, c = 32 * w4 + r;
    f32x16 zero16;
#pragma unroll
    for (int i = 0; i < 16; ++i) zero16[i] = 0.f;
    for (int pair = blockIdx.x; pair < 256; pair += gridDim.x) {
        const int item = 2 * pair + it2, b = item >> 6, g = item & 63, lg = layer * 64 + g;
        __syncthreads();
        if (tid < 128) { const int j2 = tid >> 6, p = tid & 63, itm = 2 * pair + j2; const Disc dc = ssm_disc(P, layer * 64 + (itm & 63), p); const int o = (j2 * 64 + p) * 2;
            LA[o] = dc.ar; LA[o + 1] = dc.ai; LA16[o] = dc.a16r; LA16[o + 1] = dc.a16i; LC[o] = dc.cr; LC[o + 1] = dc.ci; }
        __syncthreads();
        LAS bf16x8* LBF = (LAS bf16x8*)(lds + 152576) + it2 * 256;
        if (w4 == 1) {
#pragma unroll
            for (int pt = 0; pt < 2; ++pt) { const int p = 32 * pt + r; const float cr = LC[(it2 * 64 + p) * 2], ci = LC[(it2 * 64 + p) * 2 + 1];
                const float* brp = P.in[19] + ((size_t)lg * 64 + p) * 16 + 4 * half; const float* bip = P.in[20] + ((size_t)lg * 64 + p) * 16 + 4 * half; const float* gm = P.in[10] + layer * D + g * 16 + 4 * half;
                float vr[8], vi[8];
#pragma unroll
                for (int j = 0; j < 8; ++j) { const int o = (j & 3) + 8 * (j >> 2); const float br = brp[o], bi = bip[o], gmv = gm[o]; vr[j] = (cr * br - ci * bi) * gmv; vi[j] = (cr * bi + ci * br) * gmv; }
                LBF[pt * 64 + lane] = pack8(vr[0], vr[1], vr[2], vr[3], vr[4], vr[5], vr[6], vr[7]); LBF[(2 + pt) * 64 + lane] = pack8(vi[0], vi[1], vi[2], vi[3], vi[4], vi[5], vi[6], vi[7]); }
        }
        LAS bf16x8* LCF = (LAS bf16x8*)(lds + 136192) + it2 * 512;
        if (w4 == 0) {
#pragma unroll
            for (int tau = 0; tau < 4; ++tau)
#pragma unroll
                for (int s = 0; s < 2; ++s) { const float* cp = (tau < 2 ? P.in[21] : P.in[22]) + ((size_t)lg * 16 + (r & 15)) * 64 + 32 * (tau & 1) + 16 * s + 4 * half; const float sg = (r < 16) ? (tau < 2 ? 1.0f : -1.0f) : 0.0f;
                    LCF[(tau * 2 + s) * 64 + lane] = pack8(cp[0] * sg, cp[1] * sg, cp[2] * sg, cp[3] * sg, cp[8] * sg, cp[9] * sg, cp[10] * sg, cp[11] * sg); }
        }
        float dsk[8];
#pragma unroll
        for (int i = 0; i < 8; ++i) { const int hh = (i & 3) + 8 * (i >> 2) + 4 * half; dsk[i] = P.in[23][lg * 16 + hh] * P.in[10][layer * D + g * 16 + hh]; }
        const size_t row0 = (size_t)b * SEQ + 16 * c;
        const LAS float* la = LA + (it2 * 64 + 4 * half) * 2;
        float xr[2][16], xi[2][16];
#pragma unroll
        for (int pt = 0; pt < 2; ++pt)
#pragma unroll
            for (int i = 0; i < 16; ++i) { xr[pt][i] = 0.f; xi[pt][i] = 0.f; }
#define SSM_STEP_UPDATE(ub, rs) do { _Pragma("unroll") for (int pt = 0; pt < 2; ++pt) { const f32x16 bur = MFMA32(LBF[pt * 64 + lane], ub, zero16), bui = MFMA32(LBF[(2 + pt) * 64 + lane], ub, zero16); \
            _Pragma("unroll") for (int q = 0; q < 4; ++q) { const f32x4 a01 = *(const LAS f32x4*)(la + (32 * pt + 8 * q) * 2), a23 = *(const LAS f32x4*)(la + (32 * pt + 8 * q) * 2 + 4); \
                const float av[8] = {a01[0], a01[1], a01[2], a01[3], a23[0], a23[1], a23[2], a23[3]}; \
                _Pragma("unroll") for (int e = 0; e < 4; ++e) { const int i = 4 * q + e; const float ar = av[2 * e], ai = av[2 * e + 1]; \
                    const float nr = ar * xr[pt][i] - ai * xi[pt][i] + (rs) * bur[i], ni = ar * xi[pt][i] + ai * xr[pt][i] + (rs) * bui[i]; xr[pt][i] = nr; xi[pt][i] = ni; } \
                __builtin_amdgcn_sched_barrier(0); } } } while (0)
        __syncthreads();
        const bf16_t* up0 = HB + row0 * D + g * 16 + 4 * half;
        s16x4 nu0 = *(const s16x4*)up0, nu1 = *(const s16x4*)(up0 + 8); ssq_t nss = SSQ[row0];
#pragma unroll 1
        for (int t0 = 0; t0 < 16; ++t0) {
            const bf16x8 ub = __builtin_shufflevector(nu0, nu1, 0, 1, 2, 3, 4, 5, 6, 7);
            const float rs = 1.0f / sqrtf((float)nss * (1.0f / (1048576.0f * 1024.0f)) + EPS);
            { const int tn = t0 < 15 ? t0 + 1 : t0; const bf16_t* up = up0 + (size_t)tn * D; nu0 = *(const s16x4*)up; nu1 = *(const s16x4*)(up + 8); nss = SSQ[row0 + tn]; }
            SSM_STEP_UPDATE(ub, rs);
        }
#pragma unroll
        for (int pt = 0; pt < 2; ++pt)
#pragma unroll
            for (int i = 0; i < 16; ++i) { const int p = 32 * pt + crow(i, half), o = (it2 * 128 + c) * 65 + p; Sre[o] = xr[pt][i]; Sim[o] = xi[pt][i]; }
        __syncthreads();
        if (tid < 128) { const int j2 = tid >> 6, p = tid & 63; const float a16r = LA16[(j2 * 64 + p) * 2], a16i = LA16[(j2 * 64 + p) * 2 + 1]; float rr = 0.f, ri = 0.f;
            for (int cc = 0; cc < 128; ++cc) { const int o = (j2 * 128 + cc) * 65 + p; const float sr = Sre[o], si = Sim[o]; Sre[o] = rr; Sim[o] = ri;
                const float nr = a16r * rr - a16i * ri + sr, ni = a16r * ri + a16i * rr + si; rr = nr; ri = ni; }
            const int itm = 2 * pair + j2; const size_t so = (((size_t)layer * NBATCH + (itm >> 6)) * 64 + (itm & 63)) * 64 + p;
            P.out[O_SRP + so] = rr; P.out[O_SIP + so] = ri; }
        __syncthreads();
#pragma unroll
        for (int pt = 0; pt < 2; ++pt)
#pragma unroll
            for (int i = 0; i < 16; ++i) { const int p = 32 * pt + crow(i, half), o = (it2 * 128 + c) * 65 + p; xr[pt][i] = Sre[o]; xi[pt][i] = Sim[o]; }
        nu0 = *(const s16x4*)up0; nu1 = *(const s16x4*)(up0 + 8); nss = SSQ[row0];
#pragma unroll 1
        for (int t0 = 0; t0 < 16; ++t0) {
            const size_t row = row0 + t0;
            const bf16x8 ub = __builtin_shufflevector(nu0, nu1, 0, 1, 2, 3, 4, 5, 6, 7);
            const float rs = 1.0f / sqrtf((float)nss * (1.0f / (1048576.0f * 1024.0f)) + EPS);
            { const int tn = t0 < 15 ? t0 + 1 : t0; const bf16_t* up = up0 + (size_t)tn * D; nu0 = *(const s16x4*)up; nu1 = *(const s16x4*)(up + 8); nss = SSQ[row0 + tn]; }
            SSM_STEP_UPDATE(ub, rs);
            f32x16 yT = zero16;
#pragma unroll
            for (int pt = 0; pt < 2; ++pt)
#pragma unroll
                for (int s = 0; s < 2; ++s) {
                    const bf16x8 xsr = pack8(xr[pt][8 * s], xr[pt][8 * s + 1], xr[pt][8 * s + 2], xr[pt][8 * s + 3], xr[pt][8 * s + 4], xr[pt][8 * s + 5], xr[pt][8 * s + 6], xr[pt][8 * s + 7]);
                    const bf16x8 xsi = pack8(xi[pt][8 * s], xi[pt][8 * s + 1], xi[pt][8 * s + 2], xi[pt][8 * s + 3], xi[pt][8 * s + 4], xi[pt][8 * s + 5], xi[pt][8 * s + 6], xi[pt][8 * s + 7]);
                    yT = MFMA32(LCF[(pt * 2 + s) * 64 + lane], xsr, yT); yT = MFMA32(LCF[((2 + pt) * 2 + s) * 64 + lane], xsi, yT); __builtin_amdgcn_sched_barrier(0); }
            f32x4 y0, y1;
#pragma unroll
            for (int i = 0; i < 4; ++i) { y0[i] = gelu_tanh_f(yT[i] + dsk[i] * (bf2f((unsigned short)ub[i]) * rs)); y1[i] = gelu_tanh_f(yT[4 + i] + dsk[4 + i] * (bf2f((unsigned short)ub[4 + i]) * rs)); }
            bf16_t* op = GACT + row * D + g * 16 + 4 * half; st_bf16x4(op, y0); st_bf16x4(op + 8, y1);
        }
#undef SSM_STEP_UPDATE
    }
}

__device__ __forceinline__ void attn_tile(const Params& P, int b, int hs, int g, int rho, int i0, int lane, bool last) {
    const bf16_t* QB = (const bf16_t*)(P.ws + WS_QB); const bf16_t* KVB = (const bf16_t*)(P.ws + WS_KVB);
    bf16_t* PO = (bf16_t*)(P.ws + WS_PO); float* PM = (float*)(P.ws + WS_PM); float* PL = (float*)(P.ws + WS_PL); bf16_t* AO = (bf16_t*)(P.ws + WS_AO);
    const int r = lane & 31, half = lane >> 5, d = 1 << (2 * g);
    const int iq = i0 + r; const size_t rowq = (size_t)b * SEQ + rho + d * iq;
    const float slope_d = exp2f(-(float)(g * 8 + hs + 1) * (1.0f / 3.0f)) * (float)d;
    f32x16 zero16;
#pragma unroll
    for (int i = 0; i < 16; ++i) zero16[i] = 0.f;
    bf16x8 qf[4];
#pragma unroll
    for (int s = 0; s < 4; ++s) qf[s] = *(const bf16x8*)(QB + rowq * NQC + g * 512 + hs * 64 + 16 * s + 8 * half);
    const int lim = iq < 128 ? iq : 128;
    float m = -1e20f, l = 0.f;
    f32x16 o0 = zero16, o1 = zero16;
    const bf16_t* vbase = KVB + ((size_t)b * SEQ + rho) * NKVC + g * 1024 + 512 + hs * 64 + r;
    bf16x8 kf[4];
    { int ik = i0 - 128 + r; ik = ik < 0 ? 0 : ik; const bf16_t* kp = KVB + ((size_t)b * SEQ + rho + d * ik) * NKVC + g * 1024 + hs * 64 + 8 * half;
#pragma unroll
      for (int s = 0; s < 4; ++s) kf[s] = *(const bf16x8*)(kp + 16 * s); }
#pragma unroll 1
    for (int kt = 0; kt < 5; ++kt) {
        f32x16 st = zero16;
#pragma unroll
        for (int s = 0; s < 4; ++s) st = MFMA32(kf[s], qf[s], st);
        { int ik = i0 - 128 + 32 * (kt < 4 ? kt + 1 : kt) + r; ik = ik < 0 ? 0 : ik; const bf16_t* kp = KVB + ((size_t)b * SEQ + rho + d * ik) * NKVC + g * 1024 + hs * 64 + 8 * half;
#pragma unroll
          for (int s = 0; s < 4; ++s) kf[s] = *(const bf16x8*)(kp + 16 * s); }
        unsigned short vr0[16], vr1[16];
#pragma unroll
        for (int s2 = 0; s2 < 2; ++s2)
#pragma unroll
            for (int j = 0; j < 8; ++j) { int key = i0 - 128 + 32 * kt + 16 * s2 + 8 * (j >> 2) + 4 * half + (j & 3); key = key < 0 ? 0 : key;
                const bf16_t* vp = vbase + (size_t)(d * key) * NKVC; vr0[8 * s2 + j] = vp[0]; vr1[8 * s2 + j] = vp[32]; }
        float tm = -1e30f;
        const int dbase = r + 128 - 32 * kt - 4 * half;
#pragma unroll
        for (int i = 0; i < 16; ++i) { const int diff = dbase - ((i & 3) + 8 * (i >> 2)); const bool valid = diff >= 0 && diff <= lim;
            const float sv = valid ? st[i] - slope_d * (float)diff : -1e30f; st[i] = sv; tm = fmaxf(tm, sv); }
        tm = fmaxf(tm, __shfl_xor(tm, 32));
        const float mn = fmaxf(m, tm), alpha = __expf(m - mn); m = mn;
        float ls = 0.f;
#pragma unroll
        for (int i = 0; i < 16; ++i) { const float p = __expf(st[i] - mn); st[i] = p; ls += p; }
        ls += __shfl_xor(ls, 32);
        l = l * alpha + ls;
#pragma unroll
        for (int i = 0; i < 16; ++i) { o0[i] *= alpha; o1[i] *= alpha; }
#pragma unroll
        for (int s2 = 0; s2 < 2; ++s2) {
            const bf16x8 pf = pack8(st[8 * s2], st[8 * s2 + 1], st[8 * s2 + 2], st[8 * s2 + 3], st[8 * s2 + 4], st[8 * s2 + 5], st[8 * s2 + 6], st[8 * s2 + 7]);
            bf16x8 v0, v1;
#pragma unroll
            for (int j = 0; j < 8; ++j) { v0[j] = (short)vr0[8 * s2 + j]; v1[j] = (short)vr1[8 * s2 + j]; }
            o0 = MFMA32(v0, pf, o0); o1 = MFMA32(v1, pf, o1);
        }
    }
    if (!last) {
        const float inv = 1.0f / l; const size_t pr = (size_t)(g - 1) * MP + rowq;
#pragma unroll
        for (int q = 0; q < 4; ++q) { const int e0 = 8 * q + 4 * half;
            st_bf16x4(PO + pr * AW + hs * 64 + e0, (f32x4){o0[4 * q] * inv, o0[4 * q + 1] * inv, o0[4 * q + 2] * inv, o0[4 * q + 3] * inv});
            st_bf16x4(PO + pr * AW + hs * 64 + 32 + e0, (f32x4){o1[4 * q] * inv, o1[4 * q + 1] * inv, o1[4 * q + 2] * inv, o1[4 * q + 3] * inv}); }
        if (half == 0) { PM[pr * 8 + hs] = m; PL[pr * 8 + hs] = l; }
    } else {
        const size_t p1 = rowq, p2 = (size_t)MP + rowq;
        const float m1 = PM[p1 * 8 + hs], l1 = PL[p1 * 8 + hs], m2 = PM[p2 * 8 + hs], l2 = PL[p2 * 8 + hs];
        const float mm = fmaxf(m, fmaxf(m1, m2)); const float w0 = __expf(m - mm), w1 = __expf(m1 - mm) * l1, w2 = __expf(m2 - mm) * l2;
        const float inv = 1.0f / (w0 * l + w1 + w2);
#pragma unroll
        for (int q = 0; q < 4; ++q)
#pragma unroll
            for (int et = 0; et < 2; ++et) { const int e0 = 32 * et + 8 * q + 4 * half;
                const u32x2 a = *(const u32x2*)(PO + p1 * AW + hs * 64 + e0), c = *(const u32x2*)(PO + p2 * AW + hs * 64 + e0);
                const float a0 = __uint_as_float(a.x << 16), a1 = __uint_as_float(a.x & 0xffff0000u), a2 = __uint_as_float(a.y << 16), a3 = __uint_as_float(a.y & 0xffff0000u);
                const float c0 = __uint_as_float(c.x << 16), c1 = __uint_as_float(c.x & 0xffff0000u), c2 = __uint_as_float(c.y << 16), c3 = __uint_as_float(c.y & 0xffff0000u);
                f32x4 v;
                v[0] = (w0 * (et ? o1[4 * q] : o0[4 * q]) + w1 * a0 + w2 * c0) * inv; v[1] = (w0 * (et ? o1[4 * q + 1] : o0[4 * q + 1]) + w1 * a1 + w2 * c1) * inv;
                v[2] = (w0 * (et ? o1[4 * q + 2] : o0[4 * q + 2]) + w1 * a2 + w2 * c2) * inv; v[3] = (w0 * (et ? o1[4 * q + 3] : o0[4 * q + 3]) + w1 * a3 + w2 * c3) * inv;
                st_bf16x4(AO + rowq * AW + hs * 64 + e0, v); }
    }
}
__device__ __forceinline__ void attn_sample_item(const Params& P, int item, int lane, LAS float* sl) {
    const bf16_t* QB = (const bf16_t*)(P.ws + WS_QB); const bf16_t* KVB = (const bf16_t*)(P.ws + WS_KVB); bf16_t* AO = (bf16_t*)(P.ws + WS_AO);
    const int b = item >> 3, hs = item & 7; const size_t row = (size_t)MP + b;
#pragma unroll
    for (int g = 0; g < 3; ++g) sl[g * 64 + lane] = bf2f(QB[row * NQC + g * 512 + hs * 64 + lane]);
    LDS_WAIT();
    float m = -1e30f;
#pragma unroll 1
    for (int g = 0; g < 3; ++g) {
        const int d = 1 << (2 * g), Lb = 128 * d; const float slope_d = exp2f(-(float)(g * 8 + hs + 1) * (1.0f / 3.0f)) * (float)d; const float* cache = P.in[4 + g];
#pragma unroll 1
        for (int ch = 0; ch < 3; ++ch) { const int kk = ch * 64 + lane; float s = -1e30f;
            if (kk <= 128) { float dot = 0.f;
                if (kk == 0) { const bf16_t* kp = KVB + row * NKVC + g * 1024 + hs * 64;
#pragma unroll 1
                    for (int e = 0; e < 64; ++e) dot += sl[g * 64 + e] * bf2f(kp[e]); }
                else { const float* kp = cache + (((size_t)b * Lb + (size_t)(128 - kk) * d) * 2 + 0) * 512 + hs * 64;
#pragma unroll 4
                    for (int e = 0; e < 64; e += 4) { const f32x4 kv = *(const f32x4*)(kp + e); const f32x4 qv = *(const LAS f32x4*)(sl + g * 64 + e); dot += (kv[0] * qv[0] + kv[1] * qv[1]) + (kv[2] * qv[2] + kv[3] * qv[3]); } }
                s = dot - slope_d * (float)kk; }
            sl[192 + g * 192 + ch * 64 + lane] = s; m = fmaxf(m, s); }
    }
    m = wave_max(m);
    float l = 0.f;
#pragma unroll 1
    for (int idx = 0; idx < 9; ++idx) { const int j = 192 + idx * 64 + lane; const float p = __expf(sl[j] - m); l += p; sl[j] = p; }
    l = wave_sum(l);
    LDS_WAIT();
    const int e4 = lane & 15, kq = lane >> 4;
    f32x4 acc4 = {0.f, 0.f, 0.f, 0.f};
#pragma unroll 1
    for (int g = 0; g < 3; ++g) {
        const int d = 1 << (2 * g), Lb = 128 * d; const float* cache = P.in[4 + g] + (((size_t)b * Lb) * 2 + 1) * 512 + hs * 64 + 4 * e4;
        if (kq == 0) { const bf16_t* vp = KVB + row * NKVC + g * 1024 + 512 + hs * 64 + 4 * e4; const float p0 = sl[192 + g * 192];
            acc4[0] += p0 * bf2f(vp[0]); acc4[1] += p0 * bf2f(vp[1]); acc4[2] += p0 * bf2f(vp[2]); acc4[3] += p0 * bf2f(vp[3]); }
#pragma unroll 8
        for (int j = 0; j < 32; ++j) { const int kk = 1 + 4 * j + kq; const float pk = sl[192 + g * 192 + kk]; const f32x4 v = *(const f32x4*)(cache + (size_t)(128 - kk) * d * 1024); acc4 += pk * v; }
    }
#pragma unroll
    for (int j = 0; j < 4; ++j) { acc4[j] += __shfl_xor(acc4[j], 16); acc4[j] += __shfl_xor(acc4[j], 32); }
    if (kq == 0) { const float inv = 1.0f / l; st_bf16x4(AO + row * AW + hs * 64 + 4 * e4, acc4 * inv); }
    LDS_WAIT();
}

__global__ void __launch_bounds__(NTHREADS, 2) yoco_fwd(Params P) {
    extern __shared__ __attribute__((aligned(16))) unsigned char shm[];
    LAS unsigned char* lds = (LAS unsigned char*)shm;
    const int tid = threadIdx.x, lane = tid & 63, wave = __builtin_amdgcn_readfirstlane(tid >> 6);
    cg::grid_group grid = cg::this_grid();
    volatile LAS unsigned* MISC = (volatile LAS unsigned*)(lds + LDS_BYTES - 64);
    if (tid < 16) MISC[tid] = 0u;
    __syncthreads();
    XcdBarrier bar = xcd_barrier_post((unsigned*)(P.ws + WS_CTL), MISC + 8);
#ifndef REP_PRO
#define REP_PRO 1
#endif
    for (int rep = 0; rep < REP_PRO; ++rep) { prologue(P, lds, lane, wave); __syncthreads(); }
    grid.sync();
    ssq_t* SSQ = (ssq_t*)(P.ws + WS_SSQ);
    bf16_t* HB = (bf16_t*)(P.ws + WS_HB); bf16_t* ACT = (bf16_t*)(P.ws + WS_ACT); bf16_t* GACT = (bf16_t*)(P.ws + WS_GACT);
    bf16_t* KVB = (bf16_t*)(P.ws + WS_KVB); bf16_t* QB = (bf16_t*)(P.ws + WS_QB); bf16_t* AO = (bf16_t*)(P.ws + WS_AO);
    const int gw = blockIdx.x * NWAVES + wave, NGW = gridDim.x * NWAVES;
    for (int step = 0; step < 28; ++step) {
        int l, k;
        int lane_s = threadIdx.x & 63, tid_s = threadIdx.x;
        asm volatile("" : "+v"(lane_s), "+v"(tid_s));
        int f = 0;
        if (step < 12) { l = step / 6; const int s = step % 6; k = (s == 0 || s == 4) ? 0 : (s == 1 || s == 5) ? 1 : (s == 2 ? 2 : 3); f = s >= 4; }
        else { const int s2 = step - 12; l = 2 + s2 / 8; const int s = s2 % 8; k = (s == 0 || s == 6) ? 0 : (s == 1 || s == 7) ? 1 : (s + 2); f = s >= 6; }
        if (k == 0 || k == 1 || k == 3 || k == 4 || k == 7) {
            Epi E; E.mode = EP_UP; E.nkv = 0; E.ssq_in = SSQ; E.ssq_out = SSQ; E.obf = HB; E.kvb = KVB; E.h = P.out; E.base_p = P.out; E.base_s = P.out + (size_t)MP * D; E.bias = P.in[25]; E.out = P.out; E.scale = 1.0f;
            pg8::Gemm g; g.M = MP; const bf16_t* As;
            if (k == 0) { const int i = 2 * l + f; E.mode = EP_UP; E.nkv = (l == 2 && f == 0) ? 12 : 0; E.ssq_in = SSQ + (size_t)(f ? 3 * l + 2 : 3 * l) * SSQ_STRIDE; E.obf = ACT;
                g.A = HB; g.Bt = E.nkv ? wkv_ptr(P.ws) : wup_ptr(P.ws, i); g.N = 2 * FF + E.nkv * 256; g.K = D; As = HB + (size_t)MP * D; }
            else if (k == 1) { const int i = 2 * l + f; E.mode = EP_RES; E.scale = 0.5f; if (l == 0 && f == 0) { E.base_p = P.in[0]; E.base_s = P.in[1]; }
                E.ssq_out = SSQ + (size_t)(f ? 3 * l + 3 : 3 * l + 1) * SSQ_STRIDE; E.obf = HB;
                g.A = ACT; g.Bt = (const bf16_t*)(P.ws + WS_WDN + (size_t)i * SZ_DN); g.N = D; g.K = FF; As = ACT + (size_t)MP * FF; }
            else if (k == 3) { E.mode = EP_GLU; E.bias = P.in[25] + l * 2 * D; E.ssq_out = SSQ + (size_t)(3 * l + 2) * SSQ_STRIDE; E.obf = HB;
                g.A = GACT; g.Bt = (const bf16_t*)(P.ws + WS_WGLU + (size_t)l * SZ_GLU); g.N = 2 * D; g.K = D; As = GACT + (size_t)MP * D; }
            else if (k == 4) { E.mode = EP_Q; E.ssq_in = SSQ + (size_t)(3 * l + 1) * SSQ_STRIDE; E.obf = QB;
                g.A = HB; g.Bt = (const bf16_t*)(P.ws + WS_WQ + (size_t)(l - 2) * SZ_Q); g.N = NQC; g.K = D; As = HB + (size_t)MP * D; }
            else { E.mode = EP_RES; E.scale = 1.0f; E.ssq_out = SSQ + (size_t)(3 * l + 2) * SSQ_STRIDE; E.obf = HB;
                g.A = AO; g.Bt = (const bf16_t*)(P.ws + WS_WO + (size_t)(l - 2) * SZ_O); g.N = D; g.K = AW; As = AO + (size_t)MP * AW; }
            pg8::StaticOrder S; S.init(g.M, g.N, (int)gridDim.x, (int)blockIdx.x);
#ifndef REP_UP
#define REP_UP 1
#endif
            for (int rep = 0; rep < ((k == 0) ? REP_UP : 1); ++rep)
            pg8::gemm_phase<Epi, pg8::StaticOrder>(lds, g, S, E);
            small_gemm(E, As, g.Bt, g.K, lane_s, wave, lds);
        } else if (k == 2) {
            const ssq_t* ssq = SSQ + (size_t)(3 * l + 1) * SSQ_STRIDE;
            for (int it = blockIdx.x + gridDim.x * wave; it < NSMP * 64; it += NGW) ssm_sample_item(P, l, it, lane_s, ssq);
#ifndef REP_SSM
#define REP_SSM 1
#endif
            for (int rep = 0; rep < REP_SSM; ++rep)
            ssm_prompt(P, l, lds, ssq, tid_s, lane_s, wave);
        } else if (k == 5) {
            for (int it = blockIdx.x + gridDim.x * wave; it < NSMP * 8; it += NGW) attn_sample_item(P, it, lane_s, (LAS float*)(lds + wave * 4096));
#ifndef REP_ATT
#define REP_ATT 1
#endif
            for (int rep = 0; rep < REP_ATT; ++rep) {
                const int per = (64 * 128 + (int)gridDim.x - 1) / (int)gridDim.x, lo = blockIdx.x * per, hi = (lo + per < 64 * 128) ? lo + per : 64 * 128;
                for (;;) { int id = 0; if (lane_s == 0) id = (int)__hip_atomic_fetch_add((LAS unsigned*)(lds + LDS_BYTES - 64) + rep, 1u, __ATOMIC_RELAXED, __HIP_MEMORY_SCOPE_WORKGROUP); id = __builtin_amdgcn_readfirstlane(id) + lo; if (id >= hi) break;
                    const int bh = id >> 7, r = id & 127, g = 1 + (r >> 6), r2 = r & 63; const int rho = (g == 1) ? (r2 >> 4) : (r2 >> 2), itile = (g == 1) ? (r2 & 15) : (r2 & 3);
                    attn_tile(P, bh >> 3, bh & 7, g, rho, 32 * itile, lane_s, false); } }
        } else {
            for (int rep = 0; rep < REP_ATT; ++rep) {
                const int per = (64 * 64 + (int)gridDim.x - 1) / (int)gridDim.x, lo = blockIdx.x * per, hi = (lo + per < 64 * 64) ? lo + per : 64 * 64;
                for (;;) { int id = 0; if (lane_s == 0) id = (int)__hip_atomic_fetch_add((LAS unsigned*)(lds + LDS_BYTES - 64) + rep, 1u, __ATOMIC_RELAXED, __HIP_MEMORY_SCOPE_WORKGROUP); id = __builtin_amdgcn_readfirstlane(id) + lo; if (id >= hi) break;
                    const int bh = id >> 6, itile = id & 63; attn_tile(P, bh >> 3, bh & 7, 0, 0, 32 * itile, lane_s, true); } }
        }
        if (k == 5 || k == 6) { __syncthreads(); if (tid_s < 4) ((LAS unsigned*)(lds + LDS_BYTES - 64))[tid_s] = 0u; }
        xcd_barrier(bar);
    }
    final_norm(P, lane, wave);
}

extern "C" void kernel_launch(void* const* d_in, const int* in_sizes, int n_in, void* d_out, int out_size, void* d_ws, size_t ws_size, hipStream_t stream) {
    static int grid = 0;
    if (grid == 0) {
        if (n_in != 29 || (size_t)out_size != O_END || ws_size < WS_END) { fprintf(stderr, "kernel_launch: unexpected shapes (n_in %d, out %d, ws %zu; need 29, %zu, >= %zu)\n", n_in, out_size, ws_size, (size_t)O_END, (size_t)WS_END); grid = -1; return; }
        int dev = 0, cus = 0, per_cu = 0;
        if (hipGetDevice(&dev) != hipSuccess || hipDeviceGetAttribute(&cus, hipDeviceAttributeMultiprocessorCount, dev) != hipSuccess) { grid = -1; return; }
        if (hipFuncSetAttribute((const void*)yoco_fwd, hipFuncAttributeMaxDynamicSharedMemorySize, LDS_BYTES) != hipSuccess) { fprintf(stderr, "kernel_launch: hipFuncSetAttribute failed\n"); grid = -1; return; }
        if (hipOccupancyMaxActiveBlocksPerMultiprocessor(&per_cu, (const void*)yoco_fwd, NTHREADS, LDS_BYTES) != hipSuccess || per_cu < 1) { fprintf(stderr, "kernel_launch: occupancy query says %d\n", per_cu); per_cu = 1; }
        (void)hipGetLastError();
        grid = cus;
    }
    if (grid < 0) return;
    (void)hipMemsetAsync((char*)d_ws + WS_CTL, 0, CTL_BYTES, stream);
    Params p{};
    for (int i = 0; i < 29; ++i) p.in[i] = (const float*)d_in[i];
    p.out = (float*)d_out; p.ws = (unsigned char*)d_ws;
    void* args[] = {&p};
    hipError_t e = hipLaunchCooperativeKernel((const void*)yoco_fwd, dim3(grid), dim3(NTHREADS), args, LDS_BYTES, stream);
    if (e != hipSuccess) fprintf(stderr, "kernel_launch: cooperative launch failed: %s (grid %d)\n", hipGetErrorString(e), grid);
}
```
